# Optimizing an MI355X kernel written in HIP

```python
import math
import jax, jax.numpy as jnp
from jax import lax
import numpy as np

D_MODEL = 1024
BATCH = 8
SEQ = 4096
DEPTH = 2

N_META = 16
N_BRANCH = 4
BRANCH_W = 512
CHUNK = 32
EPS = 1e-6
GLA_HEADS = 4
GLA_DK = 64
GLA_DV = 128
GLA_RANK = 16
GLA_TAU = 16.0
HG_HEADS = 4
HG_DK = 128
HG_DV = 128
S5_GROUP = 16
S5_GROUPS = BRANCH_W // S5_GROUP
S5_STATE = 64
LRU_BLOCKS = 8
LRU_BW = BRANCH_W // LRU_BLOCKS
CONV_W = 4
LRU_C = 8.0

IN_SIZES = (
    GLA_HEADS * GLA_DK, GLA_HEADS * GLA_DK, GLA_HEADS * GLA_DV, GLA_RANK, BRANCH_W,
    HG_HEADS * HG_DK, HG_HEADS * HG_DK, HG_HEADS * HG_DV, BRANCH_W,
    BRANCH_W, BRANCH_W,
    BRANCH_W, BRANCH_W,
    N_BRANCH * D_MODEL,
)
IN_WIDTH = sum(IN_SIZES)

kernel_name = 'hybrid_gla_hgrn2_s5_rglru_meta'


def _rms_norm(x, gain):
    x32 = x.astype(jnp.float32)
    y = x32 * lax.rsqrt(jnp.mean(x32 * x32, axis=-1, keepdims=True) + EPS)
    return (y * gain.astype(jnp.float32)).astype(x.dtype)


def _to_heads(t, heads):
    b, s, _ = t.shape
    return t.reshape(b, s, heads, -1).transpose(0, 2, 1, 3)


def _from_heads(t):
    b, h, s, d = t.shape
    return t.transpose(0, 2, 1, 3).reshape(b, s, h * d)


def _chunked_gated_linear_attention(q, k, v, log_f):
    f32 = jnp.float32
    q, k, v, log_f = (t.astype(f32) for t in (q, k, v, log_f))
    t_len = q.shape[2]
    pad = (-t_len) % CHUNK
    padw = ((0, 0), (0, 0), (pad, 0), (0, 0))
    q, k, v, log_f = (jnp.pad(t, padw) for t in (q, k, v, log_f))
    bsz, heads, t_pad, dk = q.shape
    dv = v.shape[-1]
    n = t_pad // CHUNK
    q, k, v, log_f = (t.reshape(bsz, heads, n, CHUNK, t.shape[-1]) for t in (q, k, v, log_f))
    g_cum = jnp.cumsum(log_f, axis=3)
    g_last = g_cum[:, :, :, -1:, :]
    q_dec = q * jnp.exp(g_cum)
    k_inv = k * jnp.exp(-g_cum)
    k_end = k * jnp.exp(g_last - g_cum)
    causal = jnp.tril(jnp.ones((CHUNK, CHUNK), dtype=bool))
    scores = jnp.where(causal, jnp.einsum('bhncd,bhnsd->bhncs', q_dec, k_inv), 0.0)
    o_intra = jnp.einsum('bhncs,bhnsv->bhncv', scores, v)
    kv = jnp.einsum('bhncd,bhncv->nbhdv', k_end, v)
    decay = jnp.exp(g_last[:, :, :, 0, :]).transpose(2, 0, 1, 3)

    def step(state, inp):
        d, upd = inp
        return d[..., None] * state + upd, state

    _, s_start = lax.scan(step, jnp.zeros((bsz, heads, dk, dv), f32), (decay, kv))
    o_inter = jnp.einsum('bhncd,nbhdv->bhncv', q_dec, s_start)
    o = (o_intra + o_inter).reshape(bsz, heads, t_pad, dv)
    return o[:, :, pad:]


def _gla_branch(q, k, v, lr, gate, w_lr, b_lr, norm_g):
    log_a = jax.nn.log_sigmoid((lr @ w_lr + b_lr).astype(jnp.float32)) / GLA_TAU
    o = _chunked_gated_linear_attention(
        _to_heads(q, GLA_HEADS) * (GLA_DK ** -0.5), _to_heads(k, GLA_HEADS),
        _to_heads(v, GLA_HEADS), _to_heads(log_a, GLA_HEADS))
    o = _rms_norm(o, norm_g[:, None, :])
    return _from_heads(o).astype(gate.dtype) * jax.nn.silu(gate)


def _hgrn2_branch(q, f_logit, i_in, gate, lb, norm_g):
    f = lb + (1.0 - lb) * jax.nn.sigmoid(f_logit.astype(jnp.float32))
    log_f = jnp.log(f)
    k = 1.0 - f
    o = _chunked_gated_linear_attention(
        _to_heads(q, HG_HEADS), _to_heads(k, HG_HEADS),
        _to_heads(i_in, HG_HEADS), _to_heads(log_f, HG_HEADS))
    o = _rms_norm(o, norm_g[:, None, :])
    return _from_heads(o).astype(gate.dtype) * jax.nn.silu(gate)


def _complex_linear_combine(e1, e2):
    a1r, a1i, b1r, b1i = e1
    a2r, a2i, b2r, b2i = e2
    return (a2r * a1r - a2i * a1i,
            a2r * a1i + a2i * a1r,
            a2r * b1r - a2i * b1i + b2r,
            a2r * b1i + a2i * b1r + b2i)


def _s5_branch(u, gate, lam_re, lam_im, log_dt, b_re, b_im, c_re, c_im, d_skip, glu_w, glu_b):
    f32 = jnp.float32
    bsz, t_len, _ = u.shape
    u32 = u.astype(f32).reshape(bsz, t_len, S5_GROUPS, S5_GROUP)
    lr, li = lam_re.astype(f32), lam_im.astype(f32)
    dt = jnp.exp(log_dt.astype(f32))[:, None]
    mag = jnp.exp(lr * dt)
    ab_re, ab_im = mag * jnp.cos(li * dt), mag * jnp.sin(li * dt)
    nr, ni = ab_re - 1.0, ab_im
    den = lr * lr + li * li
    cr, ci = (nr * lr + ni * li) / den, (ni * lr - nr * li) / den
    br, bi = b_re.astype(f32), b_im.astype(f32)
    bb_re = cr[..., None] * br - ci[..., None] * bi
    bb_im = cr[..., None] * bi + ci[..., None] * br
    bu_re = jnp.einsum('btgc,gnc->tbgn', u32, bb_re)
    bu_im = jnp.einsum('btgc,gnc->tbgn', u32, bb_im)
    a_shape = (t_len, 1, S5_GROUPS, S5_STATE)
    a_re = jnp.broadcast_to(ab_re[None, None], a_shape)
    a_im = jnp.broadcast_to(ab_im[None, None], a_shape)
    _, _, h_re, h_im = lax.associative_scan(_complex_linear_combine, (a_re, a_im, bu_re, bu_im), axis=0)
    y = (jnp.einsum('tbgn,gcn->btgc', h_re, c_re.astype(f32))
         - jnp.einsum('tbgn,gcn->btgc', h_im, c_im.astype(f32)))
    y = y.reshape(bsz, t_len, BRANCH_W) + d_skip.astype(f32) * u32.reshape(bsz, t_len, BRANCH_W)
    y = jax.nn.gelu(y)
    y = y * jax.nn.sigmoid(y @ glu_w.astype(f32) + glu_b.astype(f32))
    return y.astype(gate.dtype) * jax.nn.silu(gate)


def _real_linear_combine(e1, e2):
    a1, b1 = e1
    a2, b2 = e2
    return a1 * a2, a2 * b1 + b2


def _rglru_branch(xb, gate, conv_w, conv_b, wa, ba, wx, bx, lam):
    f32 = jnp.float32
    bsz, t_len, width = xb.shape
    xp = jnp.pad(xb, ((0, 0), (CONV_W - 1, 0), (0, 0)))
    xc = conv_b + sum(xp[:, CONV_W - 1 - j: CONV_W - 1 - j + t_len, :] * conv_w[j] for j in range(CONV_W))
    xc32 = xc.astype(f32)
    blocks = xc32.reshape(bsz, t_len, LRU_BLOCKS, LRU_BW)
    r = jax.nn.sigmoid(jnp.einsum('btki,kij->btkj', blocks, wa.astype(f32)).reshape(bsz, t_len, width) + ba)
    i_g = jax.nn.sigmoid(jnp.einsum('btki,kij->btkj', blocks, wx.astype(f32)).reshape(bsz, t_len, width) + bx)
    log_a = -LRU_C * r * jax.nn.softplus(-lam.astype(f32))
    a = jnp.exp(log_a)
    inp = jnp.sqrt(-jnp.expm1(2.0 * log_a)) * (i_g * xc32)
    _, h = lax.associative_scan(_real_linear_combine, (a.transpose(1, 0, 2), inp.transpose(1, 0, 2)), axis=0)
    return h.transpose(1, 0, 2).astype(gate.dtype) * jax.nn.silu(gate)


def _hybrid_layer(h, norm_g, w_in, w_branch, w_out, gla_w_lr, gla_b_lr, gla_norm, hg_norm, hg_lb,
                  s5_lambda_re, s5_lambda_im, s5_log_dt, s5_b_re, s5_b_im, s5_c_re, s5_c_im,
                  s5_d, s5_glu_w, s5_glu_b, lru_conv_w, lru_conv_b, lru_wa, lru_ba, lru_wx, lru_bx,
                  lru_lambda):
    bsz, t_len, _ = h.shape
    z = _rms_norm(h, norm_g) @ w_in
    offsets = np.cumsum(IN_SIZES)[:-1].tolist()
    (gq, gk, gv, glr, ggate, hq, hf, hi, hgate, su, sgate, lx, lgate, mg) = jnp.split(z, offsets, axis=-1)
    y_a = _gla_branch(gq, gk, gv, glr, ggate, gla_w_lr, gla_b_lr, gla_norm)
    y_b = _hgrn2_branch(hq, hf, hi, hgate, hg_lb, hg_norm)
    y_c = _s5_branch(su, sgate, s5_lambda_re, s5_lambda_im, s5_log_dt, s5_b_re, s5_b_im,
                     s5_c_re, s5_c_im, s5_d, s5_glu_w, s5_glu_b)
    y_d = _rglru_branch(lx, lgate, lru_conv_w, lru_conv_b, lru_wa, lru_ba, lru_wx, lru_bx, lru_lambda)
    ys = jnp.stack([y_a, y_b, y_c, y_d], axis=2)
    proj = jnp.einsum('btnw,nwd->btnd', ys, w_branch)
    gates = jax.nn.sigmoid(mg.reshape(bsz, t_len, N_BRANCH, D_MODEL))
    merged = jnp.sum(gates * proj, axis=2)
    return h + merged @ w_out


def setup_inputs(seed: int = 0) -> dict:
    key = jax.random.key(seed)
    ks = iter(jax.random.split(key, 40))
    f32 = jnp.float32

    def nrm(shape, scale):
        return scale * jax.random.normal(next(ks), shape, f32)

    W, G, N = BRANCH_W, S5_GROUPS, S5_STATE
    x = nrm((BATCH, SEQ, D_MODEL), 1.0)
    meta_tokens = nrm((N_META, D_MODEL), 1.0)
    hgrn_lb_logits = nrm((DEPTH, HG_HEADS * HG_DK), 0.1)
    final_norm = 1.0 + nrm((D_MODEL,), 0.02)
    norm_g = 1.0 + nrm((DEPTH, D_MODEL), 0.02)
    w_in = nrm((DEPTH, D_MODEL, IN_WIDTH), D_MODEL ** -0.5)
    w_branch = nrm((DEPTH, N_BRANCH, W, D_MODEL), W ** -0.5)
    w_out = nrm((DEPTH, D_MODEL, D_MODEL), D_MODEL ** -0.5)
    gla_w_lr = nrm((DEPTH, GLA_RANK, GLA_HEADS * GLA_DK), GLA_RANK ** -0.5)
    gla_b_lr = nrm((DEPTH, GLA_HEADS * GLA_DK), 0.1)
    gla_norm = 1.0 + nrm((DEPTH, GLA_HEADS, GLA_DV), 0.02)
    hg_norm = 1.0 + nrm((DEPTH, HG_HEADS, HG_DV), 0.02)
    s5_lambda_re = -0.5 + nrm((DEPTH, G, N), 0.01)
    s5_lambda_im = math.pi * jnp.arange(N, dtype=f32)[None, None, :] + nrm((DEPTH, G, N), 0.01)
    s5_log_dt = jax.random.uniform(next(ks), (DEPTH, G), f32, math.log(1e-3), math.log(1e-1))
    s5_b_re = nrm((DEPTH, G, N, S5_GROUP), (2.0 * S5_GROUP) ** -0.5)
    s5_b_im = nrm((DEPTH, G, N, S5_GROUP), (2.0 * S5_GROUP) ** -0.5)
    s5_c_re = nrm((DEPTH, G, S5_GROUP, N), (2.0 * N) ** -0.5 * 4.0)
    s5_c_im = nrm((DEPTH, G, S5_GROUP, N), (2.0 * N) ** -0.5 * 4.0)
    s5_d = nrm((DEPTH, W), 1.0)
    s5_glu_w = nrm((DEPTH, W, W), W ** -0.5)
    s5_glu_b = nrm((DEPTH, W), 0.02)
    lru_conv_w = nrm((DEPTH, CONV_W, W), CONV_W ** -0.5)
    lru_conv_b = nrm((DEPTH, W), 0.02)
    lru_wa = nrm((DEPTH, LRU_BLOCKS, LRU_BW, LRU_BW), LRU_BW ** -0.5)
    lru_ba = nrm((DEPTH, W), 0.02)
    lru_wx = nrm((DEPTH, LRU_BLOCKS, LRU_BW, LRU_BW), LRU_BW ** -0.5)
    lru_bx = nrm((DEPTH, W), 0.02)
    a_c = jax.random.uniform(next(ks), (DEPTH, W), f32, 0.9, 0.999)
    a0 = a_c ** (1.0 / LRU_C)
    lru_lambda = jnp.log(a0) - jnp.log1p(-a0)
    return {
        'x': x, 'meta_tokens': meta_tokens, 'hgrn_lb_logits': hgrn_lb_logits, 'final_norm': final_norm,
        'norm_g': norm_g, 'w_in': w_in, 'w_branch': w_branch, 'w_out': w_out,
        'gla_w_lr': gla_w_lr, 'gla_b_lr': gla_b_lr, 'gla_norm': gla_norm, 'hg_norm': hg_norm,
        's5_lambda_re': s5_lambda_re, 's5_lambda_im': s5_lambda_im, 's5_log_dt': s5_log_dt,
        's5_b_re': s5_b_re, 's5_b_im': s5_b_im, 's5_c_re': s5_c_re, 's5_c_im': s5_c_im,
        's5_d': s5_d, 's5_glu_w': s5_glu_w, 's5_glu_b': s5_glu_b,
        'lru_conv_w': lru_conv_w, 'lru_conv_b': lru_conv_b, 'lru_wa': lru_wa, 'lru_ba': lru_ba,
        'lru_wx': lru_wx, 'lru_bx': lru_bx, 'lru_lambda': lru_lambda,
    }


def reference(x, meta_tokens, hgrn_lb_logits, final_norm, norm_g, w_in, w_branch, w_out,
              gla_w_lr, gla_b_lr, gla_norm, hg_norm, s5_lambda_re, s5_lambda_im, s5_log_dt,
              s5_b_re, s5_b_im, s5_c_re, s5_c_im, s5_d, s5_glu_w, s5_glu_b,
              lru_conv_w, lru_conv_b, lru_wa, lru_ba, lru_wx, lru_bx, lru_lambda):
    bsz = x.shape[0]
    meta = jnp.broadcast_to(meta_tokens.astype(x.dtype)[None], (bsz, N_META, D_MODEL))
    h = jnp.concatenate([meta, x], axis=1)
    p = jax.nn.softmax(hgrn_lb_logits.astype(jnp.float32), axis=0)
    lb_all = jnp.cumsum(p, axis=0) - p[0:1]
    for l in range(DEPTH):
        h = _hybrid_layer(h, norm_g[l], w_in[l], w_branch[l], w_out[l], gla_w_lr[l], gla_b_lr[l],
                          gla_norm[l], hg_norm[l], lb_all[l],
                          s5_lambda_re[l], s5_lambda_im[l], s5_log_dt[l], s5_b_re[l], s5_b_im[l],
                          s5_c_re[l], s5_c_im[l], s5_d[l], s5_glu_w[l], s5_glu_b[l],
                          lru_conv_w[l], lru_conv_b[l], lru_wa[l], lru_ba[l], lru_wx[l], lru_bx[l],
                          lru_lambda[l])
    return _rms_norm(h, final_norm)[:, N_META:]
```

```cpp
#include <hip/hip_runtime.h>
#include <hip/hip_cooperative_groups.h>
#include <cstdio>
#include <cstdint>
#include <cstring>
namespace cg = cooperative_groups;

typedef unsigned short bf16_t;
typedef short bf16x8 __attribute__((ext_vector_type(8)));
typedef short bf16x4 __attribute__((ext_vector_type(4)));
typedef float f32x16 __attribute__((ext_vector_type(16)));
typedef float f32x4 __attribute__((ext_vector_type(4)));
typedef unsigned u32x4 __attribute__((ext_vector_type(4)));
typedef unsigned u32x2 __attribute__((ext_vector_type(2)));

#define DI __device__ __forceinline__
#define MFMA32(a, b, c) __builtin_amdgcn_mfma_f32_32x32x16_bf16((a), (b), (c), 0, 0, 0)

constexpr int DM = 1024, NBAT = 8, SEQ = 4096, NMETA = 16;
constexpr int NB = 2;
constexpr int NGRP = NBAT / NB;
constexpr int RG = NB * SEQ;
constexpr int NCH = SEQ / 32;
constexpr int NUNIT = NB * NCH;
constexpr int ZW = 9856;
constexpr int INW = 9744;
constexpr int ZC_GQ = 0, ZC_GK = 256, ZC_GV = 512, ZC_GG = 1024, ZC_HQ = 1536, ZC_HF = 2048, ZC_HI = 2560, ZC_HG = 3072,
              ZC_SU = 3584, ZC_SG = 4096, ZC_LX = 4608, ZC_LG = 5120, ZC_LR = 5632, ZC_MG = 5760;
constexpr int MROW0 = NBAT * SEQ;
constexpr int NROWS = MROW0 + 256;
constexpr float EPS = 1e-6f;
constexpr int LDS_BYTES = 147968;
constexpr int NTHR = 512;
#ifndef SCAN_U
#define SCAN_U 32
#endif

struct Params {
  const float *x, *meta, *lbl, *fnorm, *ng, *w_in, *w_br, *w_out, *w_lr, *b_lr, *gnorm, *hnorm;
  const float *lam_re, *lam_im, *log_dt, *b_re, *b_im, *c_re, *c_im, *s5d, *gluw, *glub;
  const float *convw, *convb, *wa, *ba, *wx, *bx, *lam;
  float* out;
  char* ws;
};
constexpr size_t al256(size_t x) { return (x + 255) & ~(size_t)255; }
constexpr size_t O_ctrl = 0;
constexpr size_t O_ss = O_ctrl + al256(20480);
constexpr size_t O_hmeta = O_ss + al256((size_t)3*NROWS*4);
constexpr size_t O_hb = O_hmeta + al256((size_t)256*DM*4);
constexpr size_t O_WinT = O_hb + al256((size_t)NROWS*DM*2);
constexpr size_t O_WbT = O_WinT + al256((size_t)2*ZW*DM*2);
constexpr size_t O_WoutT = O_WbT + al256((size_t)8*DM*512*2);
constexpr size_t O_gluT = O_WoutT + al256((size_t)2*DM*DM*2);
constexpr size_t O_waT = O_gluT + al256((size_t)2*512*512*2);
constexpr size_t O_wxT = O_waT + al256((size_t)16*4096*2);
constexpr size_t O_TM = O_wxT + al256((size_t)16*4096*2);
constexpr size_t O_PS = O_TM + al256((size_t)64*512*640*2);
constexpr size_t O_AL = O_PS + al256((size_t)64*128*512*2);
constexpr size_t O_zg = O_AL + al256((size_t)64*64*2*4);
constexpr size_t O_zm = O_zg + al256((size_t)RG*ZW*2);
constexpr size_t O_ysg = O_zm + al256((size_t)256*ZW*2);
constexpr size_t O_ysm = O_ysg + al256((size_t)RG*2048*2);
constexpr size_t O_mgd = O_ysm + al256((size_t)256*2048*2);
constexpr size_t O_mgdm = O_mgd + al256((size_t)RG*DM*2);
constexpr size_t O_ygg = O_mgdm + al256((size_t)256*DM*2);
constexpr size_t O_ygm = O_ygg + al256((size_t)RG*512*2);
constexpr size_t O_kvA = O_ygm + al256((size_t)256*512*2);
constexpr size_t O_kvB = O_kvA + al256((size_t)NUNIT*32768*4);
constexpr size_t O_kvAm = O_kvB + al256((size_t)NUNIT*65536*4);
constexpr size_t O_kvBm = O_kvAm + al256((size_t)32768*4);
constexpr size_t O_decA = O_kvBm + al256((size_t)65536*4);
constexpr size_t O_decB = O_decA + al256((size_t)NUNIT*256*4);
constexpr size_t O_hloc = O_decB + al256((size_t)NUNIT*512*4);
constexpr size_t O_cumA = O_hloc + al256((size_t)RG*512*2);
constexpr size_t O_hlocm = O_cumA + al256((size_t)RG*512*2);
constexpr size_t O_cumAm = O_hlocm + al256((size_t)32*512*2);
constexpr size_t O_cha = O_cumAm + al256((size_t)32*512*2);
constexpr size_t O_chh = O_cha + al256((size_t)NUNIT*512*4);
constexpr size_t O_cin = O_chh + al256((size_t)NUNIT*512*4);
constexpr size_t O_chhm = O_cin + al256((size_t)NUNIT*512*4);
constexpr size_t O_qkA = O_chhm + al256((size_t)512*4);
constexpr size_t O_qkm = O_qkA + al256((size_t)NUNIT*16384*2);
constexpr size_t WS_NEED = O_qkm + al256((size_t)3*16384*2);
static_assert(WS_NEED <= (size_t)536870912, "workspace budget");
#define P_ctrl ((unsigned*)(p.ws + O_ctrl))
#define P_ss ((float*)(p.ws + O_ss))
#define P_hmeta ((float*)(p.ws + O_hmeta))
#define P_hb ((bf16_t*)(p.ws + O_hb))
#define P_WinT ((bf16_t*)(p.ws + O_WinT))
#define P_WbT ((bf16_t*)(p.ws + O_WbT))
#define P_WoutT ((bf16_t*)(p.ws + O_WoutT))
#define P_gluT ((bf16_t*)(p.ws + O_gluT))
#define P_waT ((bf16_t*)(p.ws + O_waT))
#define P_wxT ((bf16_t*)(p.ws + O_wxT))
#define P_TM ((bf16_t*)(p.ws + O_TM))
#define P_PS ((bf16_t*)(p.ws + O_PS))
#define P_AL ((float*)(p.ws + O_AL))
#define P_zg ((bf16_t*)(p.ws + O_zg))
#define P_zm ((bf16_t*)(p.ws + O_zm))
#define P_ysg ((bf16_t*)(p.ws + O_ysg))
#define P_ysm ((bf16_t*)(p.ws + O_ysm))
#define P_mgd ((bf16_t*)(p.ws + O_mgd))
#define P_mgdm ((bf16_t*)(p.ws + O_mgdm))
#define P_ygg ((bf16_t*)(p.ws + O_ygg))
#define P_ygm ((bf16_t*)(p.ws + O_ygm))
#define P_kvA ((float*)(p.ws + O_kvA))
#define P_kvB ((float*)(p.ws + O_kvB))
#define P_kvAm ((float*)(p.ws + O_kvAm))
#define P_kvBm ((float*)(p.ws + O_kvBm))
#define P_decA ((float*)(p.ws + O_decA))
#define P_decB ((float*)(p.ws + O_decB))
#define P_hloc ((bf16_t*)(p.ws + O_hloc))
#define P_cumA ((bf16_t*)(p.ws + O_cumA))
#define P_hlocm ((bf16_t*)(p.ws + O_hlocm))
#define P_cumAm ((bf16_t*)(p.ws + O_cumAm))
#define P_cha ((float*)(p.ws + O_cha))
#define P_chh ((float*)(p.ws + O_chh))
#define P_cin ((float*)(p.ws + O_cin))
#define P_chhm ((float*)(p.ws + O_chhm))
#define P_qkA ((bf16_t*)(p.ws + O_qkA))
#define P_qkm ((bf16_t*)(p.ws + O_qkm))


typedef __bf16 bf16v2_t __attribute__((ext_vector_type(2)));
typedef float f32v2_t __attribute__((ext_vector_type(2)));
DI bf16_t f2bf(float x) { const __bf16 b = (__bf16)x; return __builtin_bit_cast(unsigned short, b); }
DI float bf2f(bf16_t b) { return __uint_as_float(((unsigned)b) << 16); }
DI unsigned pk2(float lo, float hi) { const f32v2_t v = {lo, hi}; const bf16v2_t b = __builtin_convertvector(v, bf16v2_t); return __builtin_bit_cast(unsigned, b); }
DI float sigmoidf_(float x) { return __builtin_amdgcn_rcpf(1.f + __expf(-x)); }
DI float siluf_(float x) { return x * __builtin_amdgcn_rcpf(1.f + __expf(-x)); }
DI float logsigmoidf_(float x) { return fminf(x, 0.f) - __logf(1.f + __expf(-fabsf(x))); }
DI float softplusf_(float x) { return fmaxf(x, 0.f) + __logf(1.f + __expf(-fabsf(x))); }
DI float geluf_(float x) { const float u = 0.7978845608028654f * (x + 0.044715f * x * x * x); return x * __builtin_amdgcn_rcpf(1.f + __expf(-2.f * u)); }
DI int opq(int x) { asm volatile("" : "+v"(x)); return x; }
DI int opqs(int x) { asm volatile("" : "+s"(x)); return x; }
DI int crow(int reg, int h) { return (reg & 3) + 8 * (reg >> 2) + 4 * h; }
DI f32x16 zero16() { f32x16 z; for (int i = 0; i < 16; ++i) z[i] = 0.f; return z; }
DI bf16x8 pack8(float a0, float a1, float a2, float a3, float a4, float a5, float a6, float a7) {
  u32x4 p; p[0] = pk2(a0, a1); p[1] = pk2(a2, a3); p[2] = pk2(a4, a5); p[3] = pk2(a6, a7);
  return __builtin_bit_cast(bf16x8, p);
}

#define XB_TMO      128
#define XB_XCNT(j)  (256  + 64 * (j))
#define XB_XSUB(j)  (1280 + 64 * (j))
#define XB_XGEN(j)  (2304 + 64 * (j))
#define XB_TOP      3328
#define XB_TOPGEN   3392
#define XB_SPIN_CAP (1u << 22)
DI unsigned xb_ld(unsigned* p) { return __hip_atomic_load(p, __ATOMIC_RELAXED, __HIP_MEMORY_SCOPE_AGENT); }
DI unsigned xb_add(unsigned* p, unsigned v) { return __hip_atomic_fetch_add(p, v, __ATOMIC_RELAXED, __HIP_MEMORY_SCOPE_AGENT); }
DI unsigned xb_xcc_id() { return (unsigned)__builtin_amdgcn_s_getreg((3 << 11) | 20) & 0xFu; }
#define XB_SPIN(cond, bar) do { unsigned _sp = 0; while (cond) { __builtin_amdgcn_s_sleep(1); \
    if ((++_sp & 255u) == 0u) { if (xb_ld(&(bar)[XB_TMO])) break; if (_sp > XB_SPIN_CAP) { atomicAdd(&(bar)[XB_TMO], 1u); break; } } } } while (0)
DI void xcd_barrier_complete(unsigned* bar, unsigned x, unsigned& nloc, unsigned& nx) {
  const unsigned G = gridDim.x;
  unsigned sum, cnt, mine, sp = 0u;
  for (;;) {
    sum = 0u; cnt = 0u; mine = 0u;
#pragma unroll
    for (unsigned j = 0; j < 16; ++j) { const unsigned c = xb_ld(&bar[XB_XCNT(j)]); sum += c; cnt += (c > 0u) ? 1u : 0u; mine = (j == x) ? c : mine; }
    if (sum == G) break;
    __builtin_amdgcn_s_sleep(1);
    if ((++sp & 255u) == 0u) { if (xb_ld(&bar[XB_TMO])) break; if (sp > XB_SPIN_CAP) { atomicAdd(&bar[XB_TMO], 1u); break; } }
  }
  nloc = mine > 0u ? mine : 1u; nx = cnt > 0u ? cnt : 1u;
}
DI void gbar(unsigned* ctrl, unsigned& xcc) {
  unsigned* bar = ctrl + 1024;
  volatile __attribute__((address_space(3))) unsigned* st = (volatile __attribute__((address_space(3))) unsigned*)(unsigned)(LDS_BYTES - 32);
  asm volatile("s_waitcnt vmcnt(0)" ::: "memory");
  __syncthreads();
  if (threadIdx.x == 0) {
    __builtin_amdgcn_s_waitcnt(0);
    unsigned nloc = st[0], nx = st[1];
    if (nloc == 0u) { xcd_barrier_complete(bar, xcc, nloc, nx); st[0] = nloc; st[1] = nx; }
    const unsigned old = xb_add(&bar[XB_XSUB(xcc)], 1u);
    const unsigned gen = old / nloc;
    if (old + 1u == (gen + 1u) * nloc) {
      __builtin_amdgcn_fence(__ATOMIC_RELEASE, "agent");
      asm volatile("s_waitcnt vmcnt(0)" ::: "memory");
      const unsigned og = xb_add(&bar[XB_TOP], 1u);
      const unsigned tg = og / nx;
      if (og + 1u == (tg + 1u) * nx) xb_add(&bar[XB_TOPGEN], 1u);
      else XB_SPIN(xb_ld(&bar[XB_TOPGEN]) == tg, bar);
      __builtin_amdgcn_fence(__ATOMIC_ACQUIRE, "agent");
      xb_add(&bar[XB_XGEN(xcc)], 1u);
      asm volatile("s_waitcnt vmcnt(0)" ::: "memory");
    } else {
      XB_SPIN(xb_ld(&bar[XB_XGEN(xcc)]) == gen, bar);
      __builtin_amdgcn_fence(__ATOMIC_ACQUIRE, "agent");
      asm volatile("s_waitcnt vmcnt(0)" ::: "memory");
    }
  }
  __syncthreads();
}

DI int swz(int r, int c) { return r * 128 + ((c ^ ((r >> 1) & 7)) << 4); }

DI void gemm_main(const bf16_t* __restrict__ A, int lda, const bf16_t* __restrict__ Bt, int ldb, int K, char* lds, f32x16 (&acc)[2][2], int small = 0,
                  const bf16_t* __restrict__ gate = nullptr, int gate_ld = 0) {
  const int tid = opq((int)threadIdx.x), lane = tid & 63, w = tid >> 6, r = lane & 31, h = lane >> 5;
  const int wm = w & 3, wn = w >> 2;
  const int lrow = tid >> 3, lc = (tid & 7) ^ ((tid >> 4) & 7);
  const bf16_t* ga = A + (size_t)lrow * lda + lc * 8;
  const bf16_t* gb = Bt + (size_t)lrow * ldb + lc * 8;
  const int nk = K >> 6;
  typedef __attribute__((address_space(3))) unsigned lds_u32;
#define G_STAGE(S, KT) do { char* sb_ = lds + (S) * 49152 + tid * 16; \
    _Pragma("unroll") for (int u = 0; u < 4; ++u) __builtin_amdgcn_global_load_lds((const unsigned*)(ga + (size_t)(64 * u) * lda + (KT) * 64), (lds_u32*)(sb_ + u * 8192), 16, 0, 0); \
    _Pragma("unroll") for (int u = 0; u < 2; ++u) __builtin_amdgcn_global_load_lds((const unsigned*)(gb + (size_t)(64 * u) * ldb + (KT) * 64), (lds_u32*)(sb_ + 32768 + u * 8192), 16, 0, 0); } while (0)
#define G_COMPUTE(S) do { const char* la_ = lds + (S) * 49152; const char* lb_ = la_ + 32768; \
    if (!small) { \
    _Pragma("unroll") for (int ks = 0; ks < 4; ++ks) { \
      bf16x8 xf[2], wf[2]; \
      _Pragma("unroll") for (int j = 0; j < 2; ++j) xf[j] = *(const bf16x8*)(la_ + swz(wm * 64 + j * 32 + r, ks * 2 + h)); \
      _Pragma("unroll") for (int i = 0; i < 2; ++i) wf[i] = *(const bf16x8*)(lb_ + swz(wn * 64 + i * 32 + r, ks * 2 + h)); \
      _Pragma("unroll") for (int i = 0; i < 2; ++i) _Pragma("unroll") for (int j = 0; j < 2; ++j) acc[i][j] = MFMA32(wf[i], xf[j], acc[i][j]); } \
    } else if (wm == 0) { \
    _Pragma("unroll") for (int ks = 0; ks < 4; ++ks) { \
      const bf16x8 xf0 = *(const bf16x8*)(la_ + swz(r, ks * 2 + h)); \
      _Pragma("unroll") for (int i = 0; i < 2; ++i) { const bf16x8 wfi = *(const bf16x8*)(lb_ + swz(wn * 64 + i * 32 + r, ks * 2 + h)); acc[i][0] = MFMA32(wfi, xf0, acc[i][0]); } } \
    } } while (0)
  asm volatile("s_waitcnt vmcnt(0) lgkmcnt(0)" ::: "memory");
  __builtin_amdgcn_s_barrier();
  G_STAGE(0, 0);
  G_STAGE(1, 1);
  int s0 = 0, s1 = 1, s2 = 2;
#pragma unroll 1
  for (int kt = 0; kt < nk; ++kt) {
    if (kt + 1 < nk) asm volatile("s_waitcnt vmcnt(6)" ::: "memory");
    else asm volatile("s_waitcnt vmcnt(0)" ::: "memory");
    __builtin_amdgcn_s_barrier();
    if (kt + 2 < nk) G_STAGE(s2, kt + 2);
    else if (gate) {
      const bf16_t* gsrc = gate + (size_t)(tid >> 4) * gate_ld + (((tid & 15) ^ ((tid >> 4) & 15)) << 3);
      char* gdst = lds + s2 * 49152 + tid * 16;
      if (kt + 2 == nk) {
#pragma unroll
        for (int u = 0; u < 6; ++u) __builtin_amdgcn_global_load_lds((const unsigned*)(gsrc + (size_t)(u * 32) * gate_ld), (lds_u32*)(gdst + u * 8192), 16, 0, 0);
      } else {
#pragma unroll
        for (int u = 0; u < 2; ++u) __builtin_amdgcn_global_load_lds((const unsigned*)(gsrc + (size_t)(192 + u * 32) * gate_ld), (lds_u32*)(gdst + u * 8192), 16, 0, 0);
      }
    }
    G_COMPUTE(s0);
    const int t = s0; s0 = s1; s1 = s2; s2 = t;
  }
  asm volatile("s_waitcnt vmcnt(0) lgkmcnt(0)" ::: "memory");
  __builtin_amdgcn_s_barrier();
#undef G_STAGE
#undef G_COMPUTE
}

DI int swz32(int r, int c) { return r * 64 + ((c ^ ((r >> 2) & 3)) << 4); }
DI void gemm_main_256(const bf16_t* __restrict__ A, int lda, const bf16_t* __restrict__ Bt, int ldb, int K, char* lds, f32x16 (&acc)[2][4]) {
  const int tid = opq((int)threadIdx.x), lane = tid & 63, w = tid >> 6, r = lane & 31, h = lane >> 5;
  const int wm = w & 1, wn = w >> 1;
  const int lrow = tid >> 2, lc = (tid & 3) ^ ((tid >> 4) & 3);
  const bf16_t* ga = A + (size_t)lrow * lda + lc * 8;
  const bf16_t* gb = Bt + (size_t)lrow * ldb + lc * 8;
  const int nk = K >> 5;
  typedef __attribute__((address_space(3))) unsigned lds_u32;
#define H_STAGE(S, KT) do { char* sb_ = lds + (S) * 32768 + tid * 16; \
    _Pragma("unroll") for (int u = 0; u < 2; ++u) __builtin_amdgcn_global_load_lds((const unsigned*)(ga + (size_t)(128 * u) * lda + (KT) * 32), (lds_u32*)(sb_ + u * 8192), 16, 0, 0); \
    _Pragma("unroll") for (int u = 0; u < 2; ++u) __builtin_amdgcn_global_load_lds((const unsigned*)(gb + (size_t)(128 * u) * ldb + (KT) * 32), (lds_u32*)(sb_ + 16384 + u * 8192), 16, 0, 0); } while (0)
#define H_COMPUTE(S) do { const char* la_ = lds + (S) * 32768; const char* lb_ = la_ + 16384; \
    _Pragma("unroll") for (int ks = 0; ks < 2; ++ks) { \
      bf16x8 xf[4], wf[2]; \
      _Pragma("unroll") for (int i = 0; i < 2; ++i) wf[i] = *(const bf16x8*)(lb_ + swz32(wn * 64 + i * 32 + r, ks * 2 + h)); \
      _Pragma("unroll") for (int j = 0; j < 4; ++j) xf[j] = *(const bf16x8*)(la_ + swz32(wm * 128 + j * 32 + r, ks * 2 + h)); \
      _Pragma("unroll") for (int j = 0; j < 4; ++j) _Pragma("unroll") for (int i = 0; i < 2; ++i) acc[i][j] = MFMA32(wf[i], xf[j], acc[i][j]); } } while (0)
  asm volatile("s_waitcnt vmcnt(0) lgkmcnt(0)" ::: "memory");
  __builtin_amdgcn_s_barrier();
  H_STAGE(0, 0);
  H_STAGE(1, 1);
  H_STAGE(2, 2);
#pragma unroll 1
  for (int kt = 0; kt < nk; ++kt) {
    const int rem = nk - 1 - kt;
    if (rem >= 2) asm volatile("s_waitcnt vmcnt(8)" ::: "memory");
    else if (rem == 1) asm volatile("s_waitcnt vmcnt(4)" ::: "memory");
    else asm volatile("s_waitcnt vmcnt(0)" ::: "memory");
    __builtin_amdgcn_s_barrier();
    if (kt + 3 < nk) H_STAGE((kt + 3) & 3, kt + 3);
    H_COMPUTE(kt & 3);
  }
  asm volatile("s_waitcnt lgkmcnt(0)" ::: "memory");
  __builtin_amdgcn_s_barrier();
#undef H_STAGE
#undef H_COMPUTE
}

DI int win_origcol(int n) { return n < 1024 ? n : (n < 5632 ? n + 16 : (n < 5648 ? n - 5632 + 1024 : (n < 5760 ? -1 : n - 112))); }

DI void transpose_tile(const float* __restrict__ src, int src_ld, int k0, int n0, bool winmap, const float* __restrict__ scale,
                       bf16_t* __restrict__ dst, int dst_ld, float* t) {
  const int tid = opq((int)threadIdx.x);
  const int nn = tid & 63, kb = tid >> 6;
  int col = n0 + nn; if (winmap) col = win_origcol(col);
#pragma unroll
  for (int it = 0; it < 8; ++it) {
    const int kk = kb + 8 * it;
    float v = 0.f;
    if (col >= 0) { v = src[(size_t)(k0 + kk) * src_ld + col]; if (scale) v *= scale[k0 + kk]; }
    t[kk * 65 + nn] = v;
  }
  __syncthreads();
  const int n2 = tid >> 3, kc = tid & 7;
  u32x4 o;
#pragma unroll
  for (int e = 0; e < 4; ++e) o[e] = pk2(t[(kc * 8 + 2 * e) * 65 + n2], t[(kc * 8 + 2 * e + 1) * 65 + n2]);
  *(u32x4*)(dst + (size_t)(n0 + n2) * dst_ld + k0 + kc * 8) = o;
  __syncthreads();
}

DI void s5_precompute(const Params& p, int l, int g, char* smem) {
  float* Apr = (float*)smem;
  float* Api = Apr + 33 * 64;
  float* Cre = Api + 33 * 64;
  float* Cim = Cre + 1024;
  float* Bre = Cim + 1024;
  float* Bim = Bre + 1024;
  float* Kt = Bim + 1024;
  const int tid = opq((int)threadIdx.x);
  const int lg = l * 32 + g;
  if (tid < 64) {
    const int n = tid;
    const float lr = p.lam_re[lg * 64 + n], li = p.lam_im[lg * 64 + n], dt = expf(p.log_dt[lg]);
    const float mag = expf(lr * dt), are = mag * cosf(li * dt), aim = mag * sinf(li * dt);
    const float nr = are - 1.f, ni = aim, den = lr * lr + li * li;
    const float cr = (nr * lr + ni * li) / den, ci = (ni * lr - nr * li) / den;
    for (int c = 0; c < 16; ++c) {
      const float br = p.b_re[(lg * 64 + n) * 16 + c], bi = p.b_im[(lg * 64 + n) * 16 + c];
      Bre[n * 16 + c] = cr * br - ci * bi; Bim[n * 16 + c] = cr * bi + ci * br;
    }
  }
  for (int idx = tid; idx < 33 * 64; idx += NTHR) {
    const int m = idx >> 6, n = idx & 63;
    const float lr = p.lam_re[lg * 64 + n], li = p.lam_im[lg * 64 + n], dt = expf(p.log_dt[lg]);
    const float mg = expf(lr * dt * (float)m), ang = li * dt * (float)m;
    Apr[idx] = mg * cosf(ang); Api[idx] = mg * sinf(ang);
    if (m == 32) { P_AL[(lg * 64 + n) * 2 + 0] = Apr[idx]; P_AL[(lg * 64 + n) * 2 + 1] = Api[idx]; }
  }
  for (int idx = tid; idx < 1024; idx += NTHR) { Cre[idx] = p.c_re[lg * 1024 + idx]; Cim[idx] = p.c_im[lg * 1024 + idx]; }
  __syncthreads();
  for (int e = tid; e < 8192; e += NTHR) {
    const int m = e >> 8, c = (e >> 4) & 15, c2 = e & 15;
    float s = 0.f;
    for (int n = 0; n < 64; ++n) {
      const float ar = Apr[m * 64 + n], ai = Api[m * 64 + n], br = Bre[n * 16 + c2], bi = Bim[n * 16 + c2];
      const float wr = ar * br - ai * bi, wi = ar * bi + ai * br;
      s += Cre[c * 64 + n] * wr - Cim[c * 64 + n] * wi;
    }
    Kt[e] = s;
  }
  __syncthreads();
  bf16_t* TMg = P_TM + (size_t)lg * 512 * 640;
  {
    const int s = tid >> 4, c2 = tid & 15;
    for (int row = 0; row < 512; ++row) {
      const int j = row >> 4, c = row & 15;
      const float v = (s <= j) ? Kt[((j - s) << 8) + (c << 4) + c2] : 0.f;
      TMg[row * 640 + tid] = f2bf(v);
    }
  }
  for (int idx = tid; idx < 512 * 128; idx += NTHR) {
    const int row = idx >> 7, kk = idx & 127, j = row >> 4, c = row & 15, n = kk & 63, im = kk >> 6;
    const float ar = Apr[(j + 1) * 64 + n], ai = Api[(j + 1) * 64 + n], cr = Cre[c * 64 + n], ci = Cim[c * 64 + n];
    TMg[row * 640 + 512 + kk] = f2bf(im ? -(cr * ai + ci * ar) : (cr * ar - ci * ai));
  }
  bf16_t* Pg = P_PS + (size_t)lg * 128 * 512;
  for (int e = tid; e < 128 * 512; e += NTHR) {
    const int row = e >> 9, k = e & 511, n = row & 63, s = k >> 4, c2 = k & 15, m = 31 - s;
    const float ar = Apr[m * 64 + n], ai = Api[m * 64 + n], br = Bre[n * 16 + c2], bi = Bim[n * 16 + c2];
    Pg[e] = f2bf(row < 64 ? (ar * br - ai * bi) : (ar * bi + ai * br));
  }
  __syncthreads();
}

DI void prologue(const Params& p, char* smem) {
  const int tid = opq((int)threadIdx.x), bid = blockIdx.x, nb = gridDim.x;
  constexpr int T_WIN = 16 * 154;
  constexpr int T_WB = 8 * 16;
  constexpr int T_WO = 16 * 16;
  constexpr int T_GL = 8 * 8;
  constexpr int NT_ALL = 2 * T_WIN + 8 * T_WB + 2 * T_WO + 2 * T_GL + 32;
  float* tbuf = (float*)smem;
  constexpr int NT_HEAD = 192 * 20;
  const bool s5wg = (bid < 64) && (nb > 64);
  if (s5wg) s5_precompute(p, bid >> 5, bid & 31, smem);
  for (int it = (s5wg ? NT_HEAD + bid : (nb > 64 ? bid - 64 : bid)); it < NT_ALL; ) {
    int t = it;
    if (nb > 64) it += (it < NT_HEAD) ? (nb - 64) : nb; else it += nb;
    if (nb > 64 && t < NT_HEAD && it >= NT_HEAD) it = NT_HEAD + bid;
    if (t < 2 * T_WIN) {
      const int l = t / T_WIN, tt = t % T_WIN, kt = tt / 154, nt = tt % 154;
      transpose_tile(p.w_in + (size_t)l * DM * INW, INW, kt * 64, nt * 64, true, p.ng + l * DM, P_WinT + (size_t)l * ZW * DM, DM, tbuf);
      continue;
    }
    t -= 2 * T_WIN;
    if (t < 8 * T_WB) {
      const int lb = t / T_WB, tt = t % T_WB, kt = tt / 16, nt = tt % 16;
      transpose_tile(p.w_br + (size_t)lb * 512 * DM, DM, kt * 64, nt * 64, false, nullptr, P_WbT + (size_t)lb * DM * 512, 512, tbuf);
      continue;
    }
    t -= 8 * T_WB;
    if (t < 2 * T_WO) {
      const int l = t / T_WO, tt = t % T_WO, kt = tt / 16, nt = tt % 16;
      transpose_tile(p.w_out + (size_t)l * DM * DM, DM, kt * 64, nt * 64, false, nullptr, P_WoutT + (size_t)l * DM * DM, DM, tbuf);
      continue;
    }
    t -= 2 * T_WO;
    if (t < 2 * T_GL) {
      const int l = t / T_GL, tt = t % T_GL, kt = tt / 8, nt = tt % 8;
      transpose_tile(p.gluw + (size_t)l * 512 * 512, 512, kt * 64, nt * 64, false, nullptr, P_gluT + (size_t)l * 512 * 512, 512, tbuf);
      continue;
    }
    t -= 2 * T_GL;
    {
      const int which = t >> 4, lk = t & 15;
      transpose_tile((which ? p.wx : p.wa) + (size_t)lk * 4096, 64, 0, 0, false, nullptr, (which ? P_wxT : P_waT) + (size_t)lk * 4096, 64, tbuf);
    }
  }
  {
    const int lane = tid & 63, gw = bid * 8 + (tid >> 6), ngw = nb * 8;
    for (int row = gw; row < NROWS; row += ngw) {
      const float* src = nullptr;
      if (row < MROW0) src = p.x + (size_t)row * DM;
      else { const int j = row - MROW0; if (j >= 16 && j < 32) src = p.meta + (size_t)(j - 16) * DM; }
      float s = 0.f;
#pragma unroll
      for (int q = 0; q < 4; ++q) {
        f32x4 v = {0.f, 0.f, 0.f, 0.f};
        if (src) v = *(const f32x4*)(src + q * 256 + lane * 4);
        s += v[0] * v[0] + v[1] * v[1] + v[2] * v[2] + v[3] * v[3];
        u32x2 o; o[0] = pk2(v[0], v[1]); o[1] = pk2(v[2], v[3]);
        *(u32x2*)(P_hb + (size_t)row * DM + q * 256 + lane * 4) = o;
        if (row >= MROW0) *(f32x4*)(P_hmeta + (size_t)(row - MROW0) * DM + q * 256 + lane * 4) = v;
      }
#pragma unroll
      for (int o = 1; o < 64; o <<= 1) s += __shfl_xor(s, o);
      if (lane == 0) { P_ss[row] = s; P_ss[NROWS + row] = 0.f; P_ss[2 * NROWS + row] = 0.f; }
    }
  }
  if (nb <= 64) for (int it = bid; it < 64; it += nb) s5_precompute(p, it >> 5, it & 31, smem);
}

struct UnitD {
  const bf16_t* z; const bf16_t* halo; bf16_t* ys;
  bf16_t *kvA, *kvB; const bf16_t *sA, *sB; float *decA, *decB;
  bf16_t *hloc, *cumA; float *cha, *chh; const float* cin;
  int pad, meta, uu;
};
DI UnitD make_unit(const Params& p, int uu) {
  UnitD u;
  if (uu < NUNIT) {
    const int bl = uu / NCH, c = uu % NCH; const size_t rb = (size_t)bl * SEQ + c * 32;
    u.z = P_zg + rb * ZW; u.halo = c > 0 ? (u.z - 3 * ZW) : (P_zm + 29 * ZW); u.ys = P_ysg + rb * 2048;
    u.kvA = (bf16_t*)P_kvA + (size_t)uu * 32768; u.kvB = (bf16_t*)P_kvB + (size_t)uu * 65536;
    u.sA = (const bf16_t*)P_kvA + (size_t)(NUNIT + uu) * 32768; u.sB = (const bf16_t*)P_kvB + (size_t)(NUNIT + uu) * 65536; u.decA = P_decA + uu * 256; u.decB = P_decB + uu * 512;
    u.hloc = P_hloc + rb * 512; u.cumA = P_cumA + rb * 512; u.cha = P_cha + uu * 512; u.chh = P_chh + uu * 512; u.cin = P_cin + uu * 512;
    u.pad = 0; u.meta = 0; u.uu = uu;
  } else {
    u.z = P_zm; u.halo = nullptr; u.ys = P_ysm; u.kvA = (bf16_t*)P_kvAm; u.kvB = (bf16_t*)P_kvBm; u.sA = nullptr; u.sB = nullptr; u.decA = nullptr; u.decB = nullptr;
    u.hloc = P_hlocm; u.cumA = P_cumAm; u.cha = nullptr; u.chh = P_chhm; u.cin = nullptr; u.pad = 16; u.meta = 1; u.uu = 0;
  }
  return u;
}

template <bool IS_GLA>
DI void gcum_build(const Params& p, const UnitD& u, int l, int half, float* Gs, float* lrs) {
  const int tid = opq((int)threadIdx.x);
  const int d = tid & 255, jh = tid >> 8;
  if (IS_GLA) {
    { const int j = tid >> 4, i = tid & 15; lrs[tid] = bf2f(u.z[(size_t)j * ZW + ZC_LR + i]); }
    __syncthreads();
    float wv[16];
#pragma unroll
    for (int i = 0; i < 16; ++i) wv[i] = p.w_lr[(l * 16 + i) * 256 + d];
    const float b = p.b_lr[l * 256 + d];
#pragma unroll 4
    for (int jj = 0; jj < 16; ++jj) {
      const int j = jh * 16 + jj;
      float a = b;
#pragma unroll
      for (int i = 0; i < 16; ++i) a += lrs[j * 16 + i] * wv[i];
      Gs[j * 256 + d] = (j < u.pad) ? 0.f : logsigmoidf_(a) * (1.f / 16.f);
    }
  } else {
    const int dg = half * 256 + d;
    const float lb = (l == 0) ? 0.f : sigmoidf_(p.lbl[512 + dg] - p.lbl[dg]);
    bf16_t raw[16];
#pragma unroll
    for (int jj = 0; jj < 16; ++jj) raw[jj] = u.z[(size_t)(jh * 16 + jj) * ZW + ZC_HF + dg];
#pragma unroll
    for (int jj = 0; jj < 16; ++jj) {
      const int j = jh * 16 + jj;
      const float f = lb + (1.f - lb) * sigmoidf_(bf2f(raw[jj]));
      Gs[j * 256 + d] = (j < u.pad) ? 0.f : __logf(f);
    }
  }
  __syncthreads();
  {
    const int dd = tid & 255, sg = tid >> 8;
    float v[16], base = 0.f;
    if (sg == 1) {
#pragma unroll
      for (int j = 0; j < 16; ++j) base += Gs[j * 256 + dd];
    }
#pragma unroll
    for (int j = 0; j < 16; ++j) v[j] = Gs[(sg * 16 + j) * 256 + dd];
    __syncthreads();
    float run = base;
#pragma unroll
    for (int j = 0; j < 16; ++j) { run += v[j]; Gs[(sg * 16 + j) * 256 + dd] = run; }
  }
  __syncthreads();
}

template <bool IS_GLA>
DI float kval_raw(bf16_t raw, float lb) {
  if (IS_GLA) return bf2f(raw);
  return 1.f - (lb + (1.f - lb) * sigmoidf_(bf2f(raw)));
}
template <bool IS_GLA>
DI float kval_of(const Params& p, const UnitD& u, int l, int half, int j, int d) {
  if (IS_GLA) return bf2f(u.z[(size_t)j * ZW + ZC_GK + d]);
  const int dg = half * 256 + d;
  const float lb = (l == 0) ? 0.f : sigmoidf_(p.lbl[512 + dg] - p.lbl[dg]);
  const float xv = bf2f(u.z[(size_t)j * ZW + ZC_HF + dg]);
  return 1.f - (lb + (1.f - lb) * sigmoidf_(xv));
}

template <bool IS_GLA>
DI bf16_t* qk_block(const Params& p, const UnitD& u, int half) {
  if (u.meta) return P_qkm + (IS_GLA ? 0 : (1 + half)) * 16384;
  if (IS_GLA) return P_qkA + (size_t)u.uu * 16384;
  return P_mgd + ((size_t)u.uu * 2 + half) * 16384;
}

template <bool IS_GLA>
DI void gla_local(const Params& p, const UnitD& u, int l, int half, char* smem) {
  constexpr int NH = IS_GLA ? 4 : 2, DK = IS_GLA ? 64 : 128, NV = NH * 128, DKT = DK / 32;
  float* Gs = (float*)smem; float* lrs = (float*)(smem + 32768);
  bf16_t* kT = (bf16_t*)(smem + 34816); bf16_t* vT = (bf16_t*)(smem + 55296);
  const int tid = opq((int)threadIdx.x), lane = tid & 63, w = tid >> 6, r = lane & 31, h = lane >> 5;
  gcum_build<IS_GLA>(p, u, l, half, Gs, lrs);
  if (!u.meta && tid < 256) {
    const float dv = __expf(Gs[31 * 256 + tid]);
    if (IS_GLA) u.decA[tid] = dv; else u.decB[half * 256 + tid] = dv;
  }
  {
    const int d = tid & 255, jb = tid >> 8;
    const int kcol = IS_GLA ? (ZC_GK + d) : (ZC_HF + half * 256 + d);
    float lb = 0.f;
    if (!IS_GLA && l != 0) lb = sigmoidf_(p.lbl[512 + half * 256 + d] - p.lbl[half * 256 + d]);
    const int qcol = IS_GLA ? (ZC_GQ + d) : (ZC_HQ + half * 256 + d);
    const float qscale = IS_GLA ? 0.125f : 1.f;
    bf16_t raw[16], rawq[16];
#pragma unroll
    for (int it = 0; it < 16; ++it) { raw[it] = u.z[(size_t)(jb * 16 + it) * ZW + kcol]; rawq[it] = u.z[(size_t)(jb * 16 + it) * ZW + qcol]; }
    const float egl = __expf(Gs[31 * 256 + d]);
    bf16_t* QL = (bf16_t*)(smem + 96256); bf16_t* KL = (bf16_t*)(smem + 113152);
    float kend[16];
#pragma unroll
    for (int it = 0; it < 16; ++it) {
      const int j = jb * 16 + it;
      float kv = 0.f, qv = 0.f, kiv = 0.f;
      if (j >= u.pad) {
        const float g = Gs[j * 256 + d], kk = kval_raw<IS_GLA>(raw[it], lb);
        const float en = __expf(-g);
        kiv = kk * en;
        kv = kiv * egl;
        qv = bf2f(rawq[it]) * qscale * __builtin_amdgcn_rcpf(en);
      }
      kend[it] = kv;
      QL[j * 264 + d] = f2bf(qv); KL[j * 264 + d] = f2bf(kiv);
    }
    u32x4 k0, k1;
#pragma unroll
    for (int e = 0; e < 4; ++e) { k0[e] = pk2(kend[2 * e], kend[2 * e + 1]); k1[e] = pk2(kend[8 + 2 * e], kend[8 + 2 * e + 1]); }
    *(u32x4*)(kT + d * 40 + jb * 16) = k0; *(u32x4*)(kT + d * 40 + jb * 16 + 8) = k1;
  }
  const int vcol = IS_GLA ? ZC_GV : (ZC_HI + half * 256);
  {
    constexpr int NBATCH = NV / 256;
    const int v = tid % NV, jbase = (tid / NV) * 16;
#pragma unroll 1
    for (int bb = 0; bb < NBATCH; ++bb) {
      const int j0 = jbase + bb * 16;
      bf16_t raw[16];
#pragma unroll
      for (int i = 0; i < 16; ++i) raw[i] = u.z[(size_t)(j0 + i) * ZW + vcol + v];
      u32x4 w0, w1;
#pragma unroll
      for (int e = 0; e < 4; ++e) {
        const unsigned a0 = (j0 + 2 * e >= u.pad) ? raw[2 * e] : 0u, a1 = (j0 + 2 * e + 1 >= u.pad) ? raw[2 * e + 1] : 0u;
        const unsigned b0 = (j0 + 8 + 2 * e >= u.pad) ? raw[8 + 2 * e] : 0u, b1 = (j0 + 8 + 2 * e + 1 >= u.pad) ? raw[8 + 2 * e + 1] : 0u;
        w0[e] = a0 | (a1 << 16); w1[e] = b0 | (b1 << 16);
      }
      *(u32x4*)(vT + v * 40 + j0) = w0; *(u32x4*)(vT + v * 40 + j0 + 8) = w1;
    }
  }
  __syncthreads();
  {
    bf16_t* qkb = qk_block<IS_GLA>(p, u, half);
    const bf16_t* QL = (const bf16_t*)(smem + 96256); const bf16_t* KL = (const bf16_t*)(smem + 113152);
#pragma unroll
    for (int uu2 = 0; uu2 < 2; ++uu2) {
      const int c = tid + NTHR * uu2, row = c >> 5, chk = c & 31;
      *(u32x4*)(qkb + c * 8) = *(const u32x4*)(QL + row * 264 + chk * 8);
      *(u32x4*)(qkb + 8192 + c * 8) = *(const u32x4*)(KL + row * 264 + chk * 8);
    }
  }
  bf16_t* kvbase = IS_GLA ? u.kvA : (u.kvB + (size_t)half * 2 * 128 * 128);
#pragma unroll 1
  for (int tu = 0; tu < 4; ++tu) {
    const int tt = w * 4 + tu;
    const int dkt = tt % DKT, vt = (tt / DKT) % 4, hd = tt / (4 * DKT);
    f32x16 acc = zero16();
#pragma unroll
    for (int ks = 0; ks < 2; ++ks) {
      const bf16x8 a = *(const bf16x8*)(vT + (hd * 128 + vt * 32 + r) * 40 + ks * 16 + 8 * h);
      const bf16x8 b = *(const bf16x8*)(kT + (hd * DK + dkt * 32 + r) * 40 + ks * 16 + 8 * h);
      acc = MFMA32(b, a, acc);
    }
    bf16_t* dst = kvbase + ((size_t)hd * 128 + vt * 32 + r) * DK + dkt * 32 + 4 * h;
#pragma unroll
    for (int q = 0; q < 4; ++q) {
      u32x2 o; o[0] = pk2(acc[4 * q], acc[4 * q + 1]); o[1] = pk2(acc[4 * q + 2], acc[4 * q + 3]);
      *(u32x2*)(dst + 8 * q) = o;
    }
  }
  __syncthreads();
}

template <bool IS_GLA>
DI void gla_out(const Params& p, const UnitD& u, int l, int half, char* smem) {
  constexpr int NH = IS_GLA ? 4 : 2, DK = IS_GLA ? 64 : 128, NV = NH * 128, WPH = 8 / NH, VTP = 4 / WPH, KS = DK / 16;
  float* Gs = (float*)smem; float* lrs = (float*)(smem + 32768);
  bf16_t* qd = (bf16_t*)(smem + 34816); bf16_t* ki = (bf16_t*)(smem + 51712); bf16_t* vT = (bf16_t*)(smem + 68608);
  float* part = (float*)(smem + 109568);
  const int tid = opq((int)threadIdx.x), lane = tid & 63, w = tid >> 6, r = lane & 31, h = lane >> 5;
  (void)Gs; (void)lrs;
  bf16_t* GT = (bf16_t*)(smem + 112640);
  {
    const int gcol0 = IS_GLA ? ZC_GG : (ZC_HG + half * 256);
    constexpr int CPR = NV / 8, NCK = 32 * CPR / NTHR;
    u32x4 gt[NCK];
#pragma unroll
    for (int uu2 = 0; uu2 < NCK; ++uu2) { const int c = tid + NTHR * uu2, row = c / CPR, chk = c % CPR; gt[uu2] = *(const u32x4*)(u.z + (size_t)row * ZW + gcol0 + chk * 8); }
#pragma unroll
    for (int uu2 = 0; uu2 < NCK; ++uu2) { const int c = tid + NTHR * uu2, row = c / CPR, chk = c % CPR; *(u32x4*)(GT + row * (NV + 8) + chk * 8) = gt[uu2]; }
  }
  {
    const bf16_t* qkb = qk_block<IS_GLA>(p, u, half);
    u32x4 t0[2], t1[2];
#pragma unroll
    for (int uu2 = 0; uu2 < 2; ++uu2) { const int q = tid + NTHR * uu2; t0[uu2] = *(const u32x4*)(qkb + q * 8); t1[uu2] = *(const u32x4*)(qkb + 8192 + q * 8); }
#pragma unroll
    for (int uu2 = 0; uu2 < 2; ++uu2) { const int q = tid + NTHR * uu2, row = q >> 5, ch = q & 31; *(u32x4*)(qd + row * 264 + ch * 8) = t0[uu2]; *(u32x4*)(ki + row * 264 + ch * 8) = t1[uu2]; }
  }
  const int vcol = IS_GLA ? ZC_GV : (ZC_HI + half * 256);
  {
    constexpr int NBATCH = NV / 256;
    const int v = tid % NV, jbase = (tid / NV) * 16;
#pragma unroll 1
    for (int bb = 0; bb < NBATCH; ++bb) {
      const int j0 = jbase + bb * 16;
      bf16_t raw[16];
#pragma unroll
      for (int i = 0; i < 16; ++i) raw[i] = u.z[(size_t)(j0 + i) * ZW + vcol + v];
      u32x4 w0, w1;
#pragma unroll
      for (int e = 0; e < 4; ++e) {
        const unsigned a0 = (j0 + 2 * e >= u.pad) ? raw[2 * e] : 0u, a1 = (j0 + 2 * e + 1 >= u.pad) ? raw[2 * e + 1] : 0u;
        const unsigned b0 = (j0 + 8 + 2 * e >= u.pad) ? raw[8 + 2 * e] : 0u, b1 = (j0 + 8 + 2 * e + 1 >= u.pad) ? raw[8 + 2 * e + 1] : 0u;
        w0[e] = a0 | (a1 << 16); w1[e] = b0 | (b1 << 16);
      }
      *(u32x4*)(vT + v * 40 + j0) = w0; *(u32x4*)(vT + v * 40 + j0 + 8) = w1;
    }
  }
  __syncthreads();
  const int hd = w / WPH, sub = w % WPH;
  const int hdg = IS_GLA ? hd : (half * 2 + hd);
  f32x16 X = zero16();
#pragma unroll
  for (int ks = 0; ks < KS; ++ks) {
    const bf16x8 a = *(const bf16x8*)(ki + r * 264 + hd * DK + ks * 16 + 8 * h);
    const bf16x8 b = *(const bf16x8*)(qd + r * 264 + hd * DK + ks * 16 + 8 * h);
    X = MFMA32(a, b, X);
  }
#pragma unroll
  for (int reg = 0; reg < 16; ++reg) if (crow(reg, h) > r) X[reg] = 0.f;
  bf16x8 xs[2];
  xs[0] = pack8(X[0], X[1], X[2], X[3], X[4], X[5], X[6], X[7]);
  xs[1] = pack8(X[8], X[9], X[10], X[11], X[12], X[13], X[14], X[15]);
  f32x16 o[VTP];
  const bf16_t* Sbase = (IS_GLA ? u.sA : u.sB) + (size_t)hdg * 128 * DK;
#pragma unroll
  for (int vt = 0; vt < VTP; ++vt) {
    const int vg = sub * VTP + vt;
    o[vt] = zero16();
#pragma unroll
    for (int st = 0; st < 2; ++st) {
      const bf16x4 lo = *(const bf16x4*)(vT + (hd * 128 + vg * 32 + r) * 40 + 16 * st + 4 * h);
      const bf16x4 hi = *(const bf16x4*)(vT + (hd * 128 + vg * 32 + r) * 40 + 16 * st + 8 + 4 * h);
      const bf16x8 pb = __builtin_shufflevector(lo, hi, 0, 1, 2, 3, 4, 5, 6, 7);
      o[vt] = MFMA32(xs[st], pb, o[vt]);
    }
    if (!u.meta) {
      const bf16_t* Sp = Sbase + (size_t)(vg * 32 + r) * DK + 8 * h;
      bf16x8 sb[KS];
#pragma unroll
      for (int ks = 0; ks < KS; ++ks) sb[ks] = *(const bf16x8*)(Sp + ks * 16);
#pragma unroll
      for (int ks = 0; ks < KS; ++ks) {
        const bf16x8 a = *(const bf16x8*)(qd + r * 264 + hd * DK + ks * 16 + 8 * h);
        o[vt] = MFMA32(a, sb[ks], o[vt]);
      }
    }
  }
#pragma unroll
  for (int reg = 0; reg < 16; ++reg) {
    float s = 0.f;
#pragma unroll
    for (int vt = 0; vt < VTP; ++vt) s += o[vt][reg] * o[vt][reg];
#pragma unroll
    for (int off = 1; off < 32; off <<= 1) s += __shfl_xor(s, off);
    if (r == 0) part[w * 32 + crow(reg, h)] = s;
  }
  __syncthreads();
  const float* gn = (IS_GLA ? p.gnorm : p.hnorm) + (l * 4 + hdg) * 128;
  const int yoff = IS_GLA ? 0 : (512 + half * 256);
#pragma unroll
  for (int reg = 0; reg < 16; ++reg) {
    const int c = crow(reg, h);
    float tot = 0.f;
#pragma unroll
    for (int ww = 0; ww < WPH; ++ww) tot += part[(hd * WPH + ww) * 32 + c];
    const float rsq = rsqrtf(tot * (1.f / 128.f) + EPS);
#pragma unroll
    for (int vt = 0; vt < VTP; ++vt) {
      const int v = (sub * VTP + vt) * 32 + r;
      bf16_t* gp = GT + c * (NV + 8) + hd * 128 + v;
      const float gate = bf2f(*gp);
      *gp = f2bf(o[vt][reg] * rsq * gn[v] * siluf_(gate));
    }
  }
  __syncthreads();
  {
    constexpr int CPR = NV / 8, NCK = 32 * CPR / NTHR;
#pragma unroll
    for (int uu2 = 0; uu2 < NCK; ++uu2) {
      const int c = tid + NTHR * uu2, row = c / CPR, chk = c % CPR;
      *(u32x4*)(u.ys + (size_t)row * 2048 + yoff + chk * 8) = *(const u32x4*)(GT + row * (NV + 8) + chk * 8);
    }
  }
  __syncthreads();
}

DI void lru_local(const Params& p, const UnitD& u, int l, char* smem) {
  float* XC = (float*)smem;
  bf16_t* XCb = (bf16_t*)(smem + 33280);
  float* LA = (float*)(smem + 50176);
  const int tid = opq((int)threadIdx.x), lane = tid & 63, w = tid >> 6, r = lane & 31, h = lane >> 5;
#pragma unroll 1
  for (int hf = 0; hf < 2; ++hf) {
    {
      const int n = tid & 255, jh = tid >> 8, ch = hf * 256 + n, j0 = jh * 16;
      const float w0 = p.convw[(l * 4 + 0) * 512 + ch], w1 = p.convw[(l * 4 + 1) * 512 + ch], w2 = p.convw[(l * 4 + 2) * 512 + ch],
                  w3 = p.convw[(l * 4 + 3) * 512 + ch], cb = p.convb[l * 512 + ch];
      bf16_t xr[19];
#pragma unroll
      for (int i = 0; i < 19; ++i) {
        if (i < 3 && j0 == 0) xr[i] = u.halo ? u.halo[(size_t)i * ZW + ZC_LX + ch] : (bf16_t)0;
        else xr[i] = u.z[(size_t)(j0 - 3 + i) * ZW + ZC_LX + ch];
      }
      float x3 = bf2f(xr[0]), x2 = bf2f(xr[1]), x1 = bf2f(xr[2]);
#pragma unroll
      for (int jj = 0; jj < 16; ++jj) {
        const int j = j0 + jj;
        const float x0 = bf2f(xr[3 + jj]);
        const float xc = cb + w0 * x0 + w1 * x1 + w2 * x2 + w3 * x3;
        XC[j * 260 + n] = xc; XCb[j * 264 + n] = f2bf(xc);
        x3 = x2; x2 = x1; x1 = x0;
      }
    }
    __syncthreads();
    {
      const int blk = w >> 1, nt = w & 1, blkg = hf * 4 + blk;
      const bf16_t* wa = P_waT + ((size_t)(l * 8 + blkg) * 64 + nt * 32 + r) * 64 + 8 * h;
      const bf16_t* wx = P_wxT + ((size_t)(l * 8 + blkg) * 64 + nt * 32 + r) * 64 + 8 * h;
      f32x16 aa = zero16(), ax = zero16();
#pragma unroll
      for (int ks = 0; ks < 4; ++ks) {
        const bf16x8 a1 = *(const bf16x8*)(wa + ks * 16), a2 = *(const bf16x8*)(wx + ks * 16);
        const bf16x8 b = *(const bf16x8*)(XCb + r * 264 + blk * 64 + ks * 16 + 8 * h);
        aa = MFMA32(a1, b, aa); ax = MFMA32(a2, b, ax);
      }
#pragma unroll
      for (int q = 0; q < 4; ++q) {
        const int nn = blk * 64 + nt * 32 + 8 * q + 4 * h, chg = hf * 256 + nn;
        f32x4 xc = *(const f32x4*)(XC + r * 260 + nn);
        f32x4 av, iv;
#pragma unroll
        for (int i = 0; i < 4; ++i) {
          const float rr = sigmoidf_(aa[4 * q + i] + p.ba[l * 512 + chg + i]);
          const float ig = sigmoidf_(ax[4 * q + i] + p.bx[l * 512 + chg + i]);
          const float la = -8.f * rr * softplusf_(-p.lam[l * 512 + chg + i]);
          float a = __expf(la), inp = __builtin_amdgcn_sqrtf(fmaxf(1.f - __expf(2.f * la), 0.f)) * ig * xc[i];
          if (r < u.pad) { a = 1.f; inp = 0.f; }
          av[i] = a; iv[i] = inp;
        }
        *(f32x4*)(LA + r * 260 + nn) = av; *(f32x4*)(XC + r * 260 + nn) = iv;
      }
    }
    __syncthreads();
    if (tid < 256) {
      const int n = tid, ch = hf * 256 + n;
      float hh = 0.f, A = 1.f;
      for (int j = 0; j < 32; ++j) {
        const float a = LA[j * 260 + n], xv = XC[j * 260 + n];
        hh = a * hh + xv; A *= a;
        u.hloc[(size_t)j * 512 + ch] = f2bf(hh); u.cumA[(size_t)j * 512 + ch] = f2bf(A);
      }
      if (u.cha) u.cha[ch] = A;
      u.chh[ch] = hh;
    }
    __syncthreads();
  }
}

DI void lru_out(const Params& p, const UnitD& u, char* smem) {
  const int tid = opq((int)threadIdx.x);
  u32x4 hv[4], av[4], gv[4];
#pragma unroll
  for (int it = 0; it < 4; ++it) {
    const int idx = tid + NTHR * it, j = idx >> 6, c8 = idx & 63;
    hv[it] = *(const u32x4*)(u.hloc + (size_t)j * 512 + c8 * 8);
    av[it] = *(const u32x4*)(u.cumA + (size_t)j * 512 + c8 * 8);
    gv[it] = *(const u32x4*)(u.z + (size_t)j * ZW + ZC_LG + c8 * 8);
  }
#pragma unroll
  for (int it = 0; it < 4; ++it) {
    const int idx = tid + NTHR * it, j = idx >> 6, c8 = idx & 63;
    float ci[8];
#pragma unroll
    for (int e = 0; e < 8; ++e) ci[e] = u.cin ? u.cin[c8 * 8 + e] : 0.f;
    u32x4 o;
#pragma unroll
    for (int e = 0; e < 4; ++e) {
      float r2[2];
#pragma unroll
      for (int k = 0; k < 2; ++k) {
        const float hh = bf2f((bf16_t)(hv[it][e] >> (16 * k))), aa = bf2f((bf16_t)(av[it][e] >> (16 * k))), gt = bf2f((bf16_t)(gv[it][e] >> (16 * k)));
        r2[k] = (hh + aa * ci[2 * e + k]) * siluf_(gt);
      }
      o[e] = pk2(r2[0], r2[1]);
    }
    *(u32x4*)(u.ys + (size_t)j * 2048 + 1536 + c8 * 8) = o;
  }
}

DI void s5_item(const Params& p, int l, int grp, int bl, int gs, char* smem) {
  bf16_t* Ub = (bf16_t*)smem;
  float* E = (float*)(smem + 41472);
  char* FT = smem + 110112;
  const int tid = opq((int)threadIdx.x), lane = tid & 63, w = tid >> 6, r = lane & 31, h = lane >> 5;
  const int lg = l * 32 + gs;
  const bf16_t* Pg = P_PS + (size_t)lg * 128 * 512;
  const bf16_t* TMg = P_TM + (size_t)lg * 512 * 640;
  const bool wmeta = (grp == 0 && bl == 0);
  auto load_U = [&](int ut) {
#pragma unroll
    for (int it = 0; it < 4; ++it) {
      const int idx = tid + NTHR * it, m = idx >> 6, rem = idx & 63, s = rem >> 1, hv = rem & 1, uu = ut * 32 + m;
      u32x4 val = {0u, 0u, 0u, 0u};
      if (uu <= NCH) {
        const bf16_t* zr = (uu == 0) ? P_zm : (P_zg + ((size_t)bl * SEQ + (uu - 1) * 32) * ZW);
        val = *(const u32x4*)(zr + (size_t)s * ZW + ZC_SU + gs * 16 + hv * 8);
      }
      *(u32x4*)(Ub + m * 648 + s * 16 + hv * 8) = val;
    }
  };
  for (int idx = tid; idx < 33 * 64; idx += NTHR) {
    const int di = idx >> 6, ln = idx & 63, d = di - 1, rt0 = (d + (d & 1)) >> 1, ks0 = d & 1;
    *(u32x4*)(FT + di * 1024 + ln * 16) = *(const u32x4*)(TMg + (size_t)(rt0 * 32 + (ln & 31)) * 640 + ks0 * 16 + 8 * (ln >> 5));
  }
#pragma unroll 1
  for (int ut = 0; ut < 5; ++ut) {
    load_U(ut);
    __syncthreads();
    const int nt = w & 3, kh = w >> 2;
    f32x16 acc = zero16();
#pragma unroll 8
    for (int kk = 0; kk < 16; ++kk) {
      const int ks = kh * 16 + kk;
      const bf16x8 a = *(const bf16x8*)(Pg + (size_t)(nt * 32 + r) * 512 + ks * 16 + 8 * h);
      const bf16x8 b = *(const bf16x8*)(Ub + r * 648 + ks * 16 + 8 * h);
      acc = MFMA32(a, b, acc);
    }
    float* er = E + (ut * 32 + r) * 132 + nt * 32 + 4 * h;
    const bool uok = (ut * 32 + r) < 130;
    if (kh == 1 && uok) {
#pragma unroll
      for (int q = 0; q < 4; ++q) { f32x4 v = {acc[4 * q], acc[4 * q + 1], acc[4 * q + 2], acc[4 * q + 3]}; *(f32x4*)(er + 8 * q) = v; }
    }
    __syncthreads();
    if (kh == 0 && uok) {
#pragma unroll
      for (int q = 0; q < 4; ++q) {
        f32x4 v = *(const f32x4*)(er + 8 * q);
        v[0] += acc[4 * q]; v[1] += acc[4 * q + 1]; v[2] += acc[4 * q + 2]; v[3] += acc[4 * q + 3];
        *(f32x4*)(er + 8 * q) = v;
      }
    }
    __syncthreads();
  }
  if (tid < 64) {
    const int n = tid;
    const float ar = P_AL[(lg * 64 + n) * 2], ai = P_AL[(lg * 64 + n) * 2 + 1];
    float hr = 0.f, hi = 0.f;
#pragma unroll 8
    for (int uu = 0; uu <= NCH; ++uu) {
      const float er = E[uu * 132 + n], ei = E[uu * 132 + 64 + n];
      E[uu * 132 + n] = hr; E[uu * 132 + 64 + n] = hi;
      const float nhr = ar * hr - ai * hi + er, nhi = ar * hi + ai * hr + ei;
      hr = nhr; hi = nhi;
    }
  }
  __syncthreads();
#pragma unroll 1
  for (int ut = 0; ut < 5; ++ut) {
    load_U(ut);
    for (int idx = tid; idx < 32 * 128; idx += NTHR) {
      const int m = idx >> 7, kk = idx & 127;
      Ub[m * 648 + 512 + kk] = ((ut * 32 + m) < 130) ? f2bf(E[(ut * 32 + m) * 132 + kk]) : (bf16_t)0;
    }
    __syncthreads();
    f32x16 acc0 = zero16(), acc1 = zero16();
    const bf16_t* a0p = TMg + (size_t)(w * 32 + r) * 640 + 8 * h;
    const bf16_t* a1p = TMg + (size_t)((15 - w) * 32 + r) * 640 + 8 * h;
    const bf16_t* bp = Ub + r * 648 + 8 * h;
    {
      const int n0 = 2 * w + 2;
      const char* f0 = FT + (2 * w + 1) * 1024 + lane * 16;
#pragma unroll 2
      for (int ks = 0; ks < n0; ++ks) acc0 = MFMA32(*(const bf16x8*)(f0 - ks * 1024), *(const bf16x8*)(bp + ks * 16), acc0);
      const int n1 = 32 - 2 * w;
      const char* f1 = FT + (2 * (15 - w) + 1) * 1024 + lane * 16;
#pragma unroll 2
      for (int ks = 0; ks < n1; ++ks) acc1 = MFMA32(*(const bf16x8*)(f1 - ks * 1024), *(const bf16x8*)(bp + ks * 16), acc1);
#pragma unroll
      for (int ks = 32; ks < 40; ++ks) {
        const bf16x8 b = *(const bf16x8*)(bp + ks * 16);
        acc0 = MFMA32(*(const bf16x8*)(a0p + ks * 16), b, acc0); acc1 = MFMA32(*(const bf16x8*)(a1p + ks * 16), b, acc1);
      }
    }
    const int uu = ut * 32 + r;
    if (uu <= NCH && (uu > 0 || wmeta)) {
      bf16_t* yrow = (uu == 0) ? P_ygm : (P_ygg + ((size_t)bl * SEQ + (uu - 1) * 32) * 512);
#pragma unroll
      for (int rr = 0; rr < 2; ++rr) {
        const int rt = rr ? (15 - w) : w;
#pragma unroll
        for (int q = 0; q < 4; ++q) {
          const int j = rt * 2 + (q >> 1), c = 8 * (q & 1) + 4 * h, ch = gs * 16 + c;
          float yv[4];
#pragma unroll
          for (int i = 0; i < 4; ++i) {
            const float av = rr ? acc1[4 * q + i] : acc0[4 * q + i];
            const float uv = bf2f(Ub[r * 648 + j * 16 + c + i]);
            yv[i] = geluf_(av + p.s5d[l * 512 + ch + i] * uv);
          }
          u32x2 o; o[0] = pk2(yv[0], yv[1]); o[1] = pk2(yv[2], yv[3]);
          *(u32x2*)(yrow + (size_t)j * 512 + ch) = o;
        }
      }
    }
    __syncthreads();
  }
}

DI void gemm1_small_tile(const Params& p, int l, const bf16_t* A, bf16_t* out, const float* ss, int nt, char* smem) {
  const int tid = opq((int)threadIdx.x), lane = tid & 63, w = tid >> 6, r = lane & 31, h = lane >> 5, wm = w & 3, wn = w >> 2;
  f32x16 acc[2][2];
#pragma unroll
  for (int i = 0; i < 2; ++i) for (int j = 0; j < 2; ++j) acc[i][j] = zero16();
  gemm_main(A, DM, P_WinT + ((size_t)l * ZW + nt * 128) * DM, DM, DM, smem, acc);
#pragma unroll
  for (int j = 0; j < 2; ++j) {
    const int m = wm * 64 + j * 32 + r;
    const float rs = rsqrtf(ss[m] * (1.f / DM) + EPS);
#pragma unroll
    for (int i = 0; i < 2; ++i)
#pragma unroll
      for (int q = 0; q < 4; ++q) {
        const int n = nt * 128 + wn * 64 + i * 32 + 8 * q + 4 * h;
        u32x2 o; o[0] = pk2(acc[i][j][4 * q] * rs, acc[i][j][4 * q + 1] * rs); o[1] = pk2(acc[i][j][4 * q + 2] * rs, acc[i][j][4 * q + 3] * rs);
        *(u32x2*)(out + (size_t)m * ZW + n) = o;
      }
  }
}

DI void phase_gemm1(const Params& p, int l, int g, char* smem) {
  const int tid = opq((int)threadIdx.x), lane = tid & 63, w = tid >> 6, r = lane & 31, h = lane >> 5;
  const int bid = blockIdx.x, nb = gridDim.x;
  constexpr int NBIG = 32 * 38;
  for (int t = bid; t < NBIG; t += nb) {
    const int mt = t & 31, nt2 = t >> 5;
    const bf16_t* A = P_hb + ((size_t)g * RG + mt * 256) * DM;
    bf16_t* out = P_zg + (size_t)mt * 256 * ZW;
    const float* ss = P_ss + l * NROWS + g * RG + mt * 256;
    f32x16 acc[2][4];
#pragma unroll
    for (int i = 0; i < 2; ++i) for (int j = 0; j < 4; ++j) acc[i][j] = zero16();
    gemm_main_256(A, DM, P_WinT + ((size_t)l * ZW + nt2 * 256) * DM, DM, DM, smem, acc);
    const int wm = w & 1, wn = w >> 1;
#pragma unroll
    for (int j = 0; j < 4; ++j) {
      const int m = wm * 128 + j * 32 + r;
      const float rs = rsqrtf(ss[m] * (1.f / DM) + EPS);
#pragma unroll
      for (int i = 0; i < 2; ++i)
#pragma unroll
        for (int q = 0; q < 4; ++q) {
          const int n = nt2 * 256 + wn * 64 + i * 32 + 8 * q + 4 * h;
          u32x2 o; o[0] = pk2(acc[i][j][4 * q] * rs, acc[i][j][4 * q + 1] * rs); o[1] = pk2(acc[i][j][4 * q + 2] * rs, acc[i][j][4 * q + 3] * rs);
          *(u32x2*)(out + (size_t)m * ZW + n) = o;
        }
    }
  }
  const int nsmall = 32 + (g == 0 ? 77 : 0);
  const int first = (nb > 192) ? 192 : 0, nw = nb - first;
  if (bid >= first) {
    for (int s = bid - first; s < nsmall; s += nw) {
      if (s < 32) gemm1_small_tile(p, l, P_hb + ((size_t)g * RG + s * 256) * DM, P_zg + (size_t)s * 256 * ZW, P_ss + l * NROWS + g * RG + s * 256, 76, smem);
      else gemm1_small_tile(p, l, P_hb + (size_t)MROW0 * DM, P_zm, P_ss + l * NROWS + MROW0, s - 32, smem);
    }
  }
}

DI int grab_item(unsigned* ctr, char* smem) {
  volatile int* slot = (volatile int*)(smem + LDS_BYTES - 16);
  __syncthreads();
  if (threadIdx.x == 0) *slot = (int)__hip_atomic_fetch_add(ctr, 1u, __ATOMIC_RELAXED, __HIP_MEMORY_SCOPE_AGENT);
  __syncthreads();
  return *slot;
}

DI void phase_local(const Params& p, int l, int g, char* smem) {
  unsigned* ctr = P_ctrl + 64 + ((l * NGRP + g) * 2 + 0) * 16;
  const int nun = NUNIT + (g == 0 ? 1 : 0);
  const int nitem = NB * 32 + nun * 4;
  for (;;) {
    const int it = grab_item(ctr, smem);
    if (it >= nitem) break;
    if (it < NB * 32) { s5_item(p, l, g, it >> 5, it & 31, smem); continue; }
    const int s = it - NB * 32;
    const int uu = s >> 2, ty = s & 3;
    const UnitD u = make_unit(p, uu);
    if (ty == 0) gla_local<true>(p, u, l, 0, smem);
    else if (ty == 1) gla_local<false>(p, u, l, 0, smem);
    else if (ty == 2) gla_local<false>(p, u, l, 1, smem);
    else lru_local(p, u, l, smem);
  }
}

DI void glu_tile(const Params& p, int l, int bid, char* smem) {
  const int tid = opq((int)threadIdx.x), lane = tid & 63, w = tid >> 6, r = lane & 31, h = lane >> 5, wm = w & 3, wn = w >> 2;
  {
    const bf16_t* A; const bf16_t* zz; bf16_t* ys; int nt;
    if (bid < 128) { const int mt = bid & 31; nt = bid >> 5; A = P_ygg + (size_t)mt * 256 * 512; zz = P_zg + (size_t)mt * 256 * ZW; ys = P_ysg + (size_t)mt * 256 * 2048; }
    else { nt = bid - 128; A = P_ygm; zz = P_zm; ys = P_ysm; }
    f32x16 acc[2][2];
#pragma unroll
    for (int i = 0; i < 2; ++i) for (int j = 0; j < 2; ++j) acc[i][j] = zero16();
    gemm_main(A, 512, P_gluT + ((size_t)l * 512 + nt * 128) * 512, 512, 512, smem, acc, bid >= 128);
#pragma unroll
    for (int j = 0; j < 2; ++j) {
      const int m = wm * 64 + j * 32 + r;
#pragma unroll
      for (int i = 0; i < 2; ++i)
#pragma unroll
        for (int q = 0; q < 4; ++q) {
          const int n = nt * 128 + wn * 64 + i * 32 + 8 * q + 4 * h;
          const u32x2 yv = *(const u32x2*)(A + (size_t)m * 512 + n);
          const u32x2 gv = *(const u32x2*)(zz + (size_t)m * ZW + ZC_SG + n);
          float o4[4];
#pragma unroll
          for (int e = 0; e < 4; ++e) {
            const float y = bf2f((bf16_t)(yv[e >> 1] >> (16 * (e & 1))));
            const float gt = bf2f((bf16_t)(gv[e >> 1] >> (16 * (e & 1))));
            o4[e] = y * sigmoidf_(acc[i][j][4 * q + e] + p.glub[l * 512 + n + e]) * siluf_(gt);
          }
          u32x2 o; o[0] = pk2(o4[0], o4[1]); o[1] = pk2(o4[2], o4[3]);
          *(u32x2*)(ys + (size_t)m * 2048 + 1024 + n) = o;
        }
    }
  }
}

DI void phase_scan_states(const Params& p, int l, int g) {
  const int tid = opq((int)threadIdx.x), bid = blockIdx.x;
  typedef float f32x2 __attribute__((ext_vector_type(2)));
  if (tid < 384) {
    const int e = bid * 384 + tid;
    const bf16_t* pk; bf16_t* ps; const float* dec; const bf16_t* init; size_t pstride; int dstride;
    if (e < 32768) {
      const int bl = e / 16384, rem = e % 16384, el = rem * 2, hd = el / 8192, dk = el % 64;
      pk = (const bf16_t*)P_kvA + (size_t)bl * NCH * 32768 + el; ps = (bf16_t*)P_kvA + (size_t)(NUNIT + bl * NCH) * 32768 + el; pstride = 32768;
      init = (const bf16_t*)P_kvAm + el;
      dec = P_decA + (size_t)bl * NCH * 256 + hd * 64 + dk; dstride = 256;
    } else {
      const int e2 = e - 32768, bl = e2 / 32768, rem = e2 % 32768, el = rem * 2, hd = el / 16384, dk = el % 128;
      pk = (const bf16_t*)P_kvB + (size_t)bl * NCH * 65536 + el; ps = (bf16_t*)P_kvB + (size_t)(NUNIT + bl * NCH) * 65536 + el; pstride = 65536;
      init = (const bf16_t*)P_kvBm + el;
      dec = P_decB + (size_t)bl * NCH * 512 + hd * 128 + dk; dstride = 512;
    }
    f32x2 s;
    { const unsigned iv = *(const unsigned*)init; s[0] = bf2f((bf16_t)iv); s[1] = bf2f((bf16_t)(iv >> 16)); }
#pragma unroll 1
    for (int c0 = 0; c0 < NCH; c0 += SCAN_U) {
      unsigned cur[SCAN_U]; f32x2 dd[SCAN_U];
#pragma unroll
      for (int i = 0; i < SCAN_U; ++i) { cur[i] = *(const unsigned*)(pk + (size_t)(c0 + i) * pstride); dd[i] = *(const f32x2*)(dec + (size_t)(c0 + i) * dstride); }
#pragma unroll
      for (int i = 0; i < SCAN_U; ++i) {
        *(unsigned*)(ps + (size_t)(c0 + i) * pstride) = pk2(s[0], s[1]);
        s[0] = dd[i][0] * s[0] + bf2f((bf16_t)cur[i]);
        s[1] = dd[i][1] * s[1] + bf2f((bf16_t)(cur[i] >> 16));
      }
    }
  } else if (bid < 8) {
    const int e = bid * 128 + (tid - 384), bl = e >> 9, n = e & 511;
    float carry = P_chhm[n];
#pragma unroll 8
    for (int c = 0; c < NCH; ++c) {
      const int ix = (bl * NCH + c) * 512 + n;
      const float a = P_cha[ix], hh = P_chh[ix];
      P_cin[ix] = carry;
      carry = a * carry + hh;
    }
  }
}

DI void phase_output(const Params& p, int l, int g, char* smem) {
  unsigned* ctr = P_ctrl + 64 + ((l * NGRP + g) * 2 + 1) * 16;
  const int nun = NUNIT + (g == 0 ? 1 : 0);
  const int nglu = 128 + (g == 0 ? 4 : 0);
  for (;;) {
    int s = grab_item(ctr, smem);
    if (s >= nglu + nun * 4) break;
    if (s < nglu) { glu_tile(p, l, s, smem); continue; }
    s -= nglu;
    const int ty = s / nun, uu = s % nun;
    const UnitD u = make_unit(p, uu);
    if (ty == 0) gla_out<true>(p, u, l, 0, smem);
    else if (ty == 1) gla_out<false>(p, u, l, 0, smem);
    else if (ty == 2) gla_out<false>(p, u, l, 1, smem);
    else lru_out(p, u, smem);
  }
}

DI void phase_gemm2(const Params& p, int l, int g, char* smem) {
  const int tid = opq((int)threadIdx.x), lane = tid & 63, w = tid >> 6, r = lane & 31, h = lane >> 5, wm = w & 3, wn = w >> 2;
  const int ntile = 256 + (g == 0 ? 8 : 0);
  for (int t = blockIdx.x; t < ntile; t += gridDim.x) {
    const bf16_t* A; const bf16_t* zz; bf16_t* out; int nt;
    if (t < 256) { const int mt = t & 31; nt = t >> 5; A = P_ysg + (size_t)mt * 256 * 2048; zz = P_zg + (size_t)mt * 256 * ZW; out = P_mgd + (size_t)mt * 256 * DM; }
    else { nt = t - 256; A = P_ysm; zz = P_zm; out = P_mgdm; }
    f32x16 macc[2][2];
#pragma unroll
    for (int i = 0; i < 2; ++i) for (int j = 0; j < 2; ++j) macc[i][j] = zero16();
#pragma unroll 1
    for (int nb = 0; nb < 4; ++nb) {
      f32x16 acc[2][2];
#pragma unroll
      for (int i = 0; i < 2; ++i) for (int j = 0; j < 2; ++j) acc[i][j] = zero16();
      gemm_main(A + nb * 512, 2048, P_WbT + (((size_t)l * 4 + nb) * DM + nt * 128) * 512, 512, 512, smem, acc, t >= 256, zz + ZC_MG + nb * 1024 + nt * 128, ZW);
#pragma unroll
      for (int j = 0; j < 2; ++j) {
        const int m = wm * 64 + j * 32 + r;
#pragma unroll
        for (int i = 0; i < 2; ++i)
#pragma unroll
          for (int q = 0; q < 4; ++q) {
            const char* grow = (m < 192) ? (smem + 2 * 49152 + m * 256) : (smem + 0 * 49152 + (m - 192) * 256);
            const u32x2 gv = *(const u32x2*)(grow + (((wn * 8 + i * 4 + q) ^ (m & 15)) << 4) + 8 * h);
#pragma unroll
            for (int e = 0; e < 4; ++e) {
              const float gt = bf2f((bf16_t)(gv[e >> 1] >> (16 * (e & 1))));
              macc[i][j][4 * q + e] += sigmoidf_(gt) * acc[i][j][4 * q + e];
            }
          }
      }
    }
#pragma unroll
    for (int j = 0; j < 2; ++j) {
      const int m = wm * 64 + j * 32 + r;
#pragma unroll
      for (int i = 0; i < 2; ++i)
#pragma unroll
        for (int q = 0; q < 4; ++q) {
          const int n = nt * 128 + wn * 64 + i * 32 + 8 * q + 4 * h;
          u32x2 o; o[0] = pk2(macc[i][j][4 * q], macc[i][j][4 * q + 1]); o[1] = pk2(macc[i][j][4 * q + 2], macc[i][j][4 * q + 3]);
          *(u32x2*)(out + (size_t)m * DM + n) = o;
        }
    }
  }
}

DI void phase_gemm3(const Params& p, int l, int g, char* smem) {
  const int tid = opq((int)threadIdx.x), lane = tid & 63, w = tid >> 6, r = lane & 31, h = lane >> 5, wm = w & 3, wn = w >> 2;
  const int ntile = 256 + (g == 0 ? 8 : 0);
  for (int t = blockIdx.x; t < ntile; t += gridDim.x) {
    const bf16_t* A; const float* hin; float* hout; bf16_t* hb; float* ss; int nt;
    if (t < 256) {
      const int mt = t & 31; nt = t >> 5; const size_t row0 = (size_t)g * RG + mt * 256;
      A = P_mgd + (size_t)mt * 256 * DM; hin = (l == 0 ? p.x : p.out) + row0 * DM; hout = p.out + row0 * DM; hb = P_hb + row0 * DM; ss = P_ss + (l + 1) * NROWS + row0;
    } else { nt = t - 256; A = P_mgdm; hin = P_hmeta; hout = P_hmeta; hb = P_hb + (size_t)MROW0 * DM; ss = P_ss + (l + 1) * NROWS + MROW0; }
    f32x16 acc[2][2];
#pragma unroll
    for (int i = 0; i < 2; ++i) for (int j = 0; j < 2; ++j) acc[i][j] = zero16();
    f32x4 hpre[2][2][4];
#pragma unroll
    for (int j = 0; j < 2; ++j)
#pragma unroll
      for (int i = 0; i < 2; ++i)
#pragma unroll
        for (int q = 0; q < 4; ++q)
          hpre[j][i][q] = *(const f32x4*)(hin + (size_t)(wm * 64 + j * 32 + r) * DM + nt * 128 + wn * 64 + i * 32 + 8 * q + 4 * h);
    gemm_main(A, DM, P_WoutT + ((size_t)l * DM + nt * 128) * DM, DM, DM, smem, acc, t >= 256);
#pragma unroll
    for (int j = 0; j < 2; ++j) {
      const int m = wm * 64 + j * 32 + r;
      float sq = 0.f;
#pragma unroll
      for (int i = 0; i < 2; ++i)
#pragma unroll
        for (int q = 0; q < 4; ++q) {
          const int n = nt * 128 + wn * 64 + i * 32 + 8 * q + 4 * h;
          f32x4 hv = hpre[j][i][q];
#pragma unroll
          for (int e = 0; e < 4; ++e) { hv[e] += acc[i][j][4 * q + e]; sq += hv[e] * hv[e]; }
          *(f32x4*)(hout + (size_t)m * DM + n) = hv;
          if (l == 0) { u32x2 o; o[0] = pk2(hv[0], hv[1]); o[1] = pk2(hv[2], hv[3]); *(u32x2*)(hb + (size_t)m * DM + n) = o; }
        }
      sq += __shfl_xor(sq, 32);
      if (h == 0) atomicAdd(ss + m, sq);
    }
  }
}

DI void phase_final(const Params& p) {
  const int tid = opq((int)threadIdx.x), lane = tid & 63, gw = blockIdx.x * 8 + (tid >> 6), ngw = gridDim.x * 8;
  for (int row = gw; row < MROW0; row += ngw) {
    const float rs = rsqrtf(P_ss[2 * NROWS + row] * (1.f / DM) + EPS);
    float* o = p.out + (size_t)row * DM;
#pragma unroll
    for (int q = 0; q < 4; ++q) {
      f32x4 v = *(const f32x4*)(o + q * 256 + lane * 4);
      const f32x4 fn = *(const f32x4*)(p.fnorm + q * 256 + lane * 4);
      v = v * rs * fn;
      *(f32x4*)(o + q * 256 + lane * 4) = v;
    }
  }
}

__global__ void __launch_bounds__(NTHR) hybrid_mega(Params p) {
  extern __shared__ __attribute__((aligned(16))) char smem[];
  cg::grid_group grid = cg::this_grid();
  unsigned epoch = xb_xcc_id();
  if (threadIdx.x == 0) {
    volatile __attribute__((address_space(3))) unsigned* st = (volatile __attribute__((address_space(3))) unsigned*)(unsigned)(LDS_BYTES - 32);
    st[0] = 0u; st[1] = 0u;
    (void)xb_add(&(P_ctrl + 1024)[XB_XCNT(epoch)], 1u);
  }
  __syncthreads();
  prologue(p, smem);
  grid.sync();
  phase_gemm1(p, 0, 0, smem); gbar(P_ctrl, epoch);
#pragma unroll 1
  for (int l = 0; l < 2; ++l) {
#pragma unroll 1
    for (int g = 0; g < NGRP; ++g) {
      phase_local(p, l, g, smem); gbar(P_ctrl, epoch);
      phase_scan_states(p, l, g); gbar(P_ctrl, epoch);
      phase_output(p, l, g, smem); gbar(P_ctrl, epoch);
      phase_gemm2(p, l, g, smem); gbar(P_ctrl, epoch);
      phase_gemm3(p, l, g, smem);
      {
        const int gn = (g + 1) % NGRP, ln = l + (g + 1) / NGRP;
        if (ln < 2) phase_gemm1(p, ln, gn, smem);
      }
      gbar(P_ctrl, epoch);
    }
  }
  phase_final(p);
}

extern "C" void kernel_launch(void* const* d_in, const int* in_sizes, int n_in, void* d_out, int out_size, void* d_ws, size_t ws_size, hipStream_t stream) {
  Params p;
  memset(&p, 0, sizeof(p));
  const float* const* in = (const float* const*)d_in;
  p.x = in[0]; p.meta = in[1]; p.lbl = in[2]; p.fnorm = in[3]; p.ng = in[4]; p.w_in = in[5]; p.w_br = in[6]; p.w_out = in[7];
  p.w_lr = in[8]; p.b_lr = in[9]; p.gnorm = in[10]; p.hnorm = in[11]; p.lam_re = in[12]; p.lam_im = in[13]; p.log_dt = in[14];
  p.b_re = in[15]; p.b_im = in[16]; p.c_re = in[17]; p.c_im = in[18]; p.s5d = in[19]; p.gluw = in[20]; p.glub = in[21];
  p.convw = in[22]; p.convb = in[23]; p.wa = in[24]; p.ba = in[25]; p.wx = in[26]; p.bx = in[27]; p.lam = in[28];
  p.out = (float*)d_out;
  p.ws = (char*)d_ws; const size_t off = WS_NEED;
  static int grid_blocks = 0;
  if (!grid_blocks) {
    if (off > ws_size) { fprintf(stderr, "kernel_launch: workspace too small: need %zu have %zu\n", off, ws_size); grid_blocks = -1; }
    else {
      int dev = 0, cus = 0, per_cu = 0;
      hipGetDevice(&dev);
      hipDeviceGetAttribute(&cus, hipDeviceAttributeMultiprocessorCount, dev);
      hipFuncSetAttribute((const void*)hybrid_mega, hipFuncAttributeMaxDynamicSharedMemorySize, LDS_BYTES);
      hipOccupancyMaxActiveBlocksPerMultiprocessor(&per_cu, hybrid_mega, NTHR, LDS_BYTES);
      if (per_cu < 1) { fprintf(stderr, "kernel_launch: occupancy query returned %d\n", per_cu); grid_blocks = -1; }
      else grid_blocks = cus;
    }
  }
  if (grid_blocks <= 0) return;
  hipMemsetAsync(p.ws + O_ctrl, 0, 20480, stream);
  void* args[] = {&p};
  hipError_t e = hipLaunchCooperativeKernel((void*)hybrid_mega, dim3(grid_blocks), dim3(NTHR), args, LDS_BYTES, stream);
  if (e != hipSuccess) fprintf(stderr, "cooperative launch failed: %s (grid %d)\n", hipGetErrorString(e), grid_blocks);
}
```

```cpp
#include <hip/hip_runtime.h>
#include <hip/hip_cooperative_groups.h>
#include <cstdio>
#include <cstdint>
#include <cstring>
namespace cg = cooperative_groups;

typedef unsigned short bf16_t;
typedef short bf16x8 __attribute__((ext_vector_type(8)));
typedef short bf16x4 __attribute__((ext_vector_type(4)));
typedef float f32x16 __attribute__((ext_vector_type(16)));
typedef float f32x4 __attribute__((ext_vector_type(4)));
typedef unsigned u32x4 __attribute__((ext_vector_type(4)));
typedef unsigned u32x2 __attribute__((ext_vector_type(2)));

#define DI __device__ __forceinline__
#define MFMA32(a, b, c) __builtin_amdgcn_mfma_f32_32x32x16_bf16((a), (b), (c), 0, 0, 0)

constexpr int DM = 1024, NBAT = 8, SEQ = 4096, NMETA = 16;
constexpr int NB = 2;
constexpr int NGRP = NBAT / NB;
constexpr int RG = NB * SEQ;
constexpr int NCH = SEQ / 32;
constexpr int NUNIT = NB * NCH;
constexpr int ZW = 9856;
constexpr int INW = 9744;
constexpr int ZC_GQ = 0, ZC_GK = 256, ZC_GV = 512, ZC_GG = 1024, ZC_HQ = 1536, ZC_HF = 2048, ZC_HI = 2560, ZC_HG = 3072,
              ZC_SU = 3584, ZC_SG = 4096, ZC_LX = 4608, ZC_LG = 5120, ZC_LR = 5632, ZC_MG = 5760;
constexpr int MROW0 = NBAT * SEQ;
constexpr int NROWS = MROW0 + 256;
constexpr float EPS = 1e-6f;
constexpr int LDS_BYTES = 147968;
constexpr int NTHR = 512;
#ifndef SCAN_U
#define SCAN_U 32
#endif

struct Params {
  const float *x, *meta, *lbl, *fnorm, *ng, *w_in, *w_br, *w_out, *w_lr, *b_lr, *gnorm, *hnorm;
  const float *lam_re, *lam_im, *log_dt, *b_re, *b_im, *c_re, *c_im, *s5d, *gluw, *glub;
  const float *convw, *convb, *wa, *ba, *wx, *bx, *lam;
  float* out;
  char* ws;
};
constexpr size_t al256(size_t x) { return (x + 255) & ~(size_t)255; }
constexpr size_t O_ctrl = 0;
constexpr size_t O_ss = O_ctrl + al256(20480);
constexpr size_t O_hmeta = O_ss + al256((size_t)3*NROWS*4);
constexpr size_t O_hb = O_hmeta + al256((size_t)256*DM*4);
constexpr size_t O_WinT = O_hb + al256((size_t)NROWS*DM*2);
constexpr size_t O_WbT = O_WinT + al256((size_t)2*ZW*DM*2);
constexpr size_t O_WoutT = O_WbT + al256((size_t)8*DM*512*2);
constexpr size_t O_gluT = O_WoutT + al256((size_t)2*DM*DM*2);
constexpr size_t O_waT = O_gluT + al256((size_t)2*512*512*2);
constexpr size_t O_wxT = O_waT + al256((size_t)16*4096*2);
constexpr size_t O_TM = O_wxT + al256((size_t)16*4096*2);
constexpr size_t O_PS = O_TM + al256((size_t)64*512*640*2);
constexpr size_t O_AL = O_PS + al256((size_t)64*128*512*2);
constexpr size_t O_zg = O_AL + al256((size_t)64*64*2*4);
constexpr size_t O_zm = O_zg + al256((size_t)RG*ZW*2);
constexpr size_t O_ysg = O_zm + al256((size_t)256*ZW*2);
constexpr size_t O_ysm = O_ysg + al256((size_t)RG*2048*2);
constexpr size_t O_mgd = O_ysm + al256((size_t)256*2048*2);
constexpr size_t O_mgdm = O_mgd + al256((size_t)RG*DM*2);
constexpr size_t O_ygg = O_mgdm + al256((size_t)256*DM*2);
constexpr size_t O_ygm = O_ygg + al256((size_t)RG*512*2);
constexpr size_t O_kvA = O_ygm + al256((size_t)256*512*2);
constexpr size_t O_kvB = O_kvA + al256((size_t)NUNIT*32768*4);
constexpr size_t O_kvAm = O_kvB + al256((size_t)NUNIT*65536*4);
constexpr size_t O_kvBm = O_kvAm + al256((size_t)32768*4);
constexpr size_t O_decA = O_kvBm + al256((size_t)65536*4);
constexpr size_t O_decB = O_decA + al256((size_t)NUNIT*256*4);
constexpr size_t O_hloc = O_decB + al256((size_t)NUNIT*512*4);
constexpr size_t O_cumA = O_hloc + al256((size_t)RG*512*2);
constexpr size_t O_hlocm = O_cumA + al256((size_t)RG*512*2);
constexpr size_t O_cumAm = O_hlocm + al256((size_t)32*512*2);
constexpr size_t O_cha = O_cumAm + al256((size_t)32*512*2);
constexpr size_t O_chh = O_cha + al256((size_t)NUNIT*512*4);
constexpr size_t O_cin = O_chh + al256((size_t)NUNIT*512*4);
constexpr size_t O_chhm = O_cin + al256((size_t)NUNIT*512*4);
constexpr size_t O_qkA = O_chhm + al256((size_t)512*4);
constexpr size_t O_qkm = O_qkA + al256((size_t)NUNIT*16384*2);
constexpr size_t WS_NEED = O_qkm + al256((size_t)3*16384*2);
static_assert(WS_NEED <= (size_t)536870912, "workspace budget");
#define P_ctrl ((unsigned*)(p.ws + O_ctrl))
#define P_ss ((float*)(p.ws + O_ss))
#define P_hmeta ((float*)(p.ws + O_hmeta))
#define P_hb ((bf16_t*)(p.ws + O_hb))
#define P_WinT ((bf16_t*)(p.ws + O_WinT))
#define P_WbT ((bf16_t*)(p.ws + O_WbT))
#define P_WoutT ((bf16_t*)(p.ws + O_WoutT))
#define P_gluT ((bf16_t*)(p.ws + O_gluT))
#define P_waT ((bf16_t*)(p.ws + O_waT))
#define P_wxT ((bf16_t*)(p.ws + O_wxT))
#define P_TM ((bf16_t*)(p.ws + O_TM))
#define P_PS ((bf16_t*)(p.ws + O_PS))
#define P_AL ((float*)(p.ws + O_AL))
#define P_zg ((bf16_t*)(p.ws + O_zg))
#define P_zm ((bf16_t*)(p.ws + O_zm))
#define P_ysg ((bf16_t*)(p.ws + O_ysg))
#define P_ysm ((bf16_t*)(p.ws + O_ysm))
#define P_mgd ((bf16_t*)(p.ws + O_mgd))
#define P_mgdm ((bf16_t*)(p.ws + O_mgdm))
#define P_ygg ((bf16_t*)(p.ws + O_ygg))
#define P_ygm ((bf16_t*)(p.ws + O_ygm))
#define P_kvA ((float*)(p.ws + O_kvA))
#define P_kvB ((float*)(p.ws + O_kvB))
#define P_kvAm ((float*)(p.ws + O_kvAm))
#define P_kvBm ((float*)(p.ws + O_kvBm))
#define P_decA ((float*)(p.ws + O_decA))
#define P_decB ((float*)(p.ws + O_decB))
#define P_hloc ((bf16_t*)(p.ws + O_hloc))
#define P_cumA ((bf16_t*)(p.ws + O_cumA))
#define P_hlocm ((bf16_t*)(p.ws + O_hlocm))
#define P_cumAm ((bf16_t*)(p.ws + O_cumAm))
#define P_cha ((float*)(p.ws + O_cha))
#define P_chh ((float*)(p.ws + O_chh))
#define P_cin ((float*)(p.ws + O_cin))
#define P_chhm ((float*)(p.ws + O_chhm))
#define P_qkA ((bf16_t*)(p.ws + O_qkA))
#define P_qkm ((bf16_t*)(p.ws + O_qkm))


typedef __bf16 bf16v2_t __attribute__((ext_vector_type(2)));
typedef float f32v2_t __attribute__((ext_vector_type(2)));
DI bf16_t f2bf(float x) { const __bf16 b = (__bf16)x; return __builtin_bit_cast(unsigned short, b); }
DI float bf2f(bf16_t b) { return __uint_as_float(((unsigned)b) << 16); }
DI unsigned pk2(float lo, float hi) { const f32v2_t v = {lo, hi}; const bf16v2_t b = __builtin_convertvector(v, bf16v2_t); return __builtin_bit_cast(unsigned, b); }
DI float sigmoidf_(float x) { return __builtin_amdgcn_rcpf(1.f + __expf(-x)); }
DI float siluf_(float x) { return x * __builtin_amdgcn_rcpf(1.f + __expf(-x)); }
DI float logsigmoidf_(float x) { return fminf(x, 0.f) - __logf(1.f + __expf(-fabsf(x))); }
DI float softplusf_(float x) { return fmaxf(x, 0.f) + __logf(1.f + __expf(-fabsf(x))); }
DI float geluf_(float x) { const float u = 0.7978845608028654f * (x + 0.044715f * x * x * x); return x * __builtin_amdgcn_rcpf(1.f + __expf(-2.f * u)); }
DI int opq(int x) { asm volatile("" : "+v"(x)); return x; }
DI int opqs(int x) { asm volatile("" : "+s"(x)); return x; }
DI int crow(int reg, int h) { return (reg & 3) + 8 * (reg >> 2) + 4 * h; }
DI f32x16 zero16() { f32x16 z; for (int i = 0; i < 16; ++i) z[i] = 0.f; return z; }
DI bf16x8 pack8(float a0, float a1, float a2, float a3, float a4, float a5, float a6, float a7) {
  u32x4 p; p[0] = pk2(a0, a1); p[1] = pk2(a2, a3); p[2] = pk2(a4, a5); p[3] = pk2(a6, a7);
  return __builtin_bit_cast(bf16x8, p);
}

#define XB_TMO      128
#define XB_XCNT(j)  (256  + 64 * (j))
#define XB_XSUB(j)  (1280 + 64 * (j))
#define XB_XGEN(j)  (2304 + 64 * (j))
#define XB_TOP      3328
#define XB_TOPGEN   3392
#define XB_SPIN_CAP (1u << 22)
DI unsigned xb_ld(unsigned* p) { return __hip_atomic_load(p, __ATOMIC_RELAXED, __HIP_MEMORY_SCOPE_AGENT); }
DI unsigned xb_add(unsigned* p, unsigned v) { return __hip_atomic_fetch_add(p, v, __ATOMIC_RELAXED, __HIP_MEMORY_SCOPE_AGENT); }
DI unsigned xb_xcc_id() { return (unsigned)__builtin_amdgcn_s_getreg((3 << 11) | 20) & 0xFu; }
#define XB_SPIN(cond, bar) do { unsigned _sp = 0; while (cond) { __builtin_amdgcn_s_sleep(1); \
    if ((++_sp & 255u) == 0u) { if (xb_ld(&(bar)[XB_TMO])) break; if (_sp > XB_SPIN_CAP) { atomicAdd(&(bar)[XB_TMO], 1u); break; } } } } while (0)
DI void xcd_barrier_complete(unsigned* bar, unsigned x, unsigned& nloc, unsigned& nx) {
  const unsigned G = gridDim.x;
  unsigned sum, cnt, mine, sp = 0u;
  for (;;) {
    sum = 0u; cnt = 0u; mine = 0u;
#pragma unroll
    for (unsigned j = 0; j < 16; ++j) { const unsigned c = xb_ld(&bar[XB_XCNT(j)]); sum += c; cnt += (c > 0u) ? 1u : 0u; mine = (j == x) ? c : mine; }
    if (sum == G) break;
    __builtin_amdgcn_s_sleep(1);
    if ((++sp & 255u) == 0u) { if (xb_ld(&bar[XB_TMO])) break; if (sp > XB_SPIN_CAP) { atomicAdd(&bar[XB_TMO], 1u); break; } }
  }
  nloc = mine > 0u ? mine : 1u; nx = cnt > 0u ? cnt : 1u;
}
DI void gbar(unsigned* ctrl, unsigned& xcc) {
  unsigned* bar = ctrl + 1024;
  volatile __attribute__((address_space(3))) unsigned* st = (volatile __attribute__((address_space(3))) unsigned*)(unsigned)(LDS_BYTES - 32);
  asm volatile("s_waitcnt vmcnt(0)" ::: "memory");
  __syncthreads();
  if (threadIdx.x == 0) {
    __builtin_amdgcn_s_waitcnt(0);
    unsigned nloc = st[0], nx = st[1];
    if (nloc == 0u) { xcd_barrier_complete(bar, xcc, nloc, nx); st[0] = nloc; st[1] = nx; }
    const unsigned old = xb_add(&bar[XB_XSUB(xcc)], 1u);
    const unsigned gen = old / nloc;
    if (old + 1u == (gen + 1u) * nloc) {
      __builtin_amdgcn_fence(__ATOMIC_RELEASE, "agent");
      asm volatile("s_waitcnt vmcnt(0)" ::: "memory");
      const unsigned og = xb_add(&bar[XB_TOP], 1u);
      const unsigned tg = og / nx;
      if (og + 1u == (tg + 1u) * nx) xb_add(&bar[XB_TOPGEN], 1u);
      else XB_SPIN(xb_ld(&bar[XB_TOPGEN]) == tg, bar);
      __builtin_amdgcn_fence(__ATOMIC_ACQUIRE, "agent");
      xb_add(&bar[XB_XGEN(xcc)], 1u);
      asm volatile("s_waitcnt vmcnt(0)" ::: "memory");
    } else {
      XB_SPIN(xb_ld(&bar[XB_XGEN(xcc)]) == gen, bar);
      __builtin_amdgcn_fence(__ATOMIC_ACQUIRE, "agent");
      asm volatile("s_waitcnt vmcnt(0)" ::: "memory");
    }
  }
  __syncthreads();
}

DI int swz(int r, int c) { return r * 128 + ((c ^ ((r >> 1) & 7)) << 4); }

DI void gemm_main(const bf16_t* __restrict__ A, int lda, const bf16_t* __restrict__ Bt, int ldb, int K, char* lds, f32x16 (&acc)[2][2], int small = 0,
                  const bf16_t* __restrict__ gate = nullptr, int gate_ld = 0) {
  const int tid = opq((int)threadIdx.x), lane = tid & 63, w = tid >> 6, r = lane & 31, h = lane >> 5;
  const int wm = w & 3, wn = w >> 2;
  const int lrow = tid >> 3, lc = (tid & 7) ^ ((tid >> 4) & 7);
  const bf16_t* ga = A + (size_t)lrow * lda + lc * 8;
  const bf16_t* gb = Bt + (size_t)lrow * ldb + lc * 8;
  const int nk = K >> 6;
  typedef __attribute__((address_space(3))) unsigned lds_u32;
#define G_STAGE(S, KT) do { char* sb_ = lds + (S) * 49152 + tid * 16; \
    _Pragma("unroll") for (int u = 0; u < 4; ++u) __builtin_amdgcn_global_load_lds((const unsigned*)(ga + (size_t)(64 * u) * lda + (KT) * 64), (lds_u32*)(sb_ + u * 8192), 16, 0, 0); \
    _Pragma("unroll") for (int u = 0; u < 2; ++u) __builtin_amdgcn_global_load_lds((const unsigned*)(gb + (size_t)(64 * u) * ldb + (KT) * 64), (lds_u32*)(sb_ + 32768 + u * 8192), 16, 0, 0); } while (0)
#define G_COMPUTE(S) do { const char* la_ = lds + (S) * 49152; const char* lb_ = la_ + 32768; \
    if (!small) { \
    _Pragma("unroll") for (int ks = 0; ks < 4; ++ks) { \
      bf16x8 xf[2], wf[2]; \
      _Pragma("unroll") for (int j = 0; j < 2; ++j) xf[j] = *(const bf16x8*)(la_ + swz(wm * 64 + j * 32 + r, ks * 2 + h)); \
      _Pragma("unroll") for (int i = 0; i < 2; ++i) wf[i] = *(const bf16x8*)(lb_ + swz(wn * 64 + i * 32 + r, ks * 2 + h)); \
      _Pragma("unroll") for (int i = 0; i < 2; ++i) _Pragma("unroll") for (int j = 0; j < 2; ++j) acc[i][j] = MFMA32(wf[i], xf[j], acc[i][j]); } \
    } else if (wm == 0) { \
    _Pragma("unroll") for (int ks = 0; ks < 4; ++ks) { \
      const bf16x8 xf0 = *(const bf16x8*)(la_ + swz(r, ks * 2 + h)); \
      _Pragma("unroll") for (int i = 0; i < 2; ++i) { const bf16x8 wfi = *(const bf16x8*)(lb_ + swz(wn * 64 + i * 32 + r, ks * 2 + h)); acc[i][0] = MFMA32(wfi, xf0, acc[i][0]); } } \
    } } while (0)
  asm volatile("s_waitcnt vmcnt(0) lgkmcnt(0)" ::: "memory");
  __builtin_amdgcn_s_barrier();
  G_STAGE(0, 0);
  G_STAGE(1, 1);
  int s0 = 0, s1 = 1, s2 = 2;
#pragma unroll 1
  for (int kt = 0; kt < nk; ++kt) {
    if (kt + 1 < nk) asm volatile("s_waitcnt vmcnt(6)" ::: "memory");
    else asm volatile("s_waitcnt vmcnt(0)" ::: "memory");
    __builtin_amdgcn_s_barrier();
    if (kt + 2 < nk) G_STAGE(s2, kt + 2);
    else if (gate) {
      const bf16_t* gsrc = gate + (size_t)(tid >> 4) * gate_ld + (((tid & 15) ^ ((tid >> 4) & 15)) << 3);
      char* gdst = lds + s2 * 49152 + tid * 16;
      if (kt + 2 == nk) {
#pragma unroll
        for (int u = 0; u < 6; ++u) __builtin_amdgcn_global_load_lds((const unsigned*)(gsrc + (size_t)(u * 32) * gate_ld), (lds_u32*)(gdst + u * 8192), 16, 0, 0);
      } else {
#pragma unroll
        for (int u = 0; u < 2; ++u) __builtin_amdgcn_global_load_lds((const unsigned*)(gsrc + (size_t)(192 + u * 32) * gate_ld), (lds_u32*)(gdst + u * 8192), 16, 0, 0);
      }
    }
    G_COMPUTE(s0);
    const int t = s0; s0 = s1; s1 = s2; s2 = t;
  }
  asm volatile("s_waitcnt vmcnt(0) lgkmcnt(0)" ::: "memory");
  __builtin_amdgcn_s_barrier();
#undef G_STAGE
#undef G_COMPUTE
}

DI int swz32(int r, int c) { return r * 64 + ((c ^ ((r >> 2) & 3)) << 4); }
DI void gemm_main_256(const bf16_t* __restrict__ A, int lda, const bf16_t* __restrict__ Bt, int ldb, int K, char* lds, f32x16 (&acc)[2][4]) {
  const int tid = opq((int)threadIdx.x), lane = tid & 63, w = tid >> 6, r = lane & 31, h = lane >> 5;
  const int wm = w & 1, wn = w >> 1;
  const int lrow = tid >> 2, lc = (tid & 3) ^ ((tid >> 4) & 3);
  const bf16_t* ga = A + (size_t)lrow * lda + lc * 8;
  const bf16_t* gb = Bt + (size_t)lrow * ldb + lc * 8;
  const int nk = K >> 5;
  typedef __attribute__((address_space(3))) unsigned lds_u32;
#define H_STAGE(S, KT) do { char* sb_ = lds + (S) * 32768 + tid * 16; \
    _Pragma("unroll") for (int u = 0; u < 2; ++u) __builtin_amdgcn_global_load_lds((const unsigned*)(ga + (size_t)(128 * u) * lda + (KT) * 32), (lds_u32*)(sb_ + u * 8192), 16, 0, 0); \
    _Pragma("unroll") for (int u = 0; u < 2; ++u) __builtin_amdgcn_global_load_lds((const unsigned*)(gb + (size_t)(128 * u) * ldb + (KT) * 32), (lds_u32*)(sb_ + 16384 + u * 8192), 16, 0, 0); } while (0)
#define H_COMPUTE(S) do { const char* la_ = lds + (S) * 32768; const char* lb_ = la_ + 16384; \
    _Pragma("unroll") for (int ks = 0; ks < 2; ++ks) { \
      bf16x8 xf[4], wf[2]; \
      _Pragma("unroll") for (int i = 0; i < 2; ++i) wf[i] = *(const bf16x8*)(lb_ + swz32(wn * 64 + i * 32 + r, ks * 2 + h)); \
      _Pragma("unroll") for (int j = 0; j < 4; ++j) xf[j] = *(const bf16x8*)(la_ + swz32(wm * 128 + j * 32 + r, ks * 2 + h)); \
      _Pragma("unroll") for (int j = 0; j < 4; ++j) _Pragma("unroll") for (int i = 0; i < 2; ++i) acc[i][j] = MFMA32(wf[i], xf[j], acc[i][j]); } } while (0)
  asm volatile("s_waitcnt vmcnt(0) lgkmcnt(0)" ::: "memory");
  __builtin_amdgcn_s_barrier();
  H_STAGE(0, 0);
  H_STAGE(1, 1);
  H_STAGE(2, 2);
#pragma unroll 1
  for (int kt = 0; kt < nk; ++kt) {
    const int rem = nk - 1 - kt;
    if (rem >= 2) asm volatile("s_waitcnt vmcnt(8)" ::: "memory");
    else if (rem == 1) asm volatile("s_waitcnt vmcnt(4)" ::: "memory");
    else asm volatile("s_waitcnt vmcnt(0)" ::: "memory");
    __builtin_amdgcn_s_barrier();
    if (kt + 3 < nk) H_STAGE((kt + 3) & 3, kt + 3);
    H_COMPUTE(kt & 3);
  }
  asm volatile("s_waitcnt lgkmcnt(0)" ::: "memory");
  __builtin_amdgcn_s_barrier();
#undef H_STAGE
#undef H_COMPUTE
}

DI int win_origcol(int n) { return n < 1024 ? n : (n < 5632 ? n + 16 : (n < 5648 ? n - 5632 + 1024 : (n < 5760 ? -1 : n - 112))); }

DI void transpose_tile(const float* __restrict__ src, int src_ld, int k0, int n0, bool winmap, const float* __restrict__ scale,
                       bf16_t* __restrict__ dst, int dst_ld, float* t) {
  const int tid = opq((int)threadIdx.x);
  const int nn = tid & 63, kb = tid >> 6;
  int col = n0 + nn; if (winmap) col = win_origcol(col);
#pragma unroll
  for (int it = 0; it < 8; ++it) {
    const int kk = kb + 8 * it;
    float v = 0.f;
    if (col >= 0) { v = __builtin_nontemporal_load(src + (size_t)(k0 + kk) * src_ld + col); if (scale) v *= scale[k0 + kk]; }
    t[kk * 65 + nn] = v;
  }
  __syncthreads();
  const int n2 = tid >> 3, kc = tid & 7;
  u32x4 o;
#pragma unroll
  for (int e = 0; e < 4; ++e) o[e] = pk2(t[(kc * 8 + 2 * e) * 65 + n2], t[(kc * 8 + 2 * e + 1) * 65 + n2]);
  *(u32x4*)(dst + (size_t)(n0 + n2) * dst_ld + k0 + kc * 8) = o;
  __syncthreads();
}

DI void s5_precompute(const Params& p, int l, int g, char* smem) {
  float* Apr = (float*)smem;
  float* Api = Apr + 33 * 64;
  float* Cre = Api + 33 * 64;
  float* Cim = Cre + 1024;
  float* Bre = Cim + 1024;
  float* Bim = Bre + 1024;
  float* Kt = Bim + 1024;
  const int tid = opq((int)threadIdx.x);
  const int lg = l * 32 + g;
  if (tid < 64) {
    const int n = tid;
    const float lr = p.lam_re[lg * 64 + n], li = p.lam_im[lg * 64 + n], dt = expf(p.log_dt[lg]);
    const float mag = expf(lr * dt), are = mag * cosf(li * dt), aim = mag * sinf(li * dt);
    const float nr = are - 1.f, ni = aim, den = lr * lr + li * li;
    const float cr = (nr * lr + ni * li) / den, ci = (ni * lr - nr * li) / den;
    for (int c = 0; c < 16; ++c) {
      const float br = p.b_re[(lg * 64 + n) * 16 + c], bi = p.b_im[(lg * 64 + n) * 16 + c];
      Bre[n * 16 + c] = cr * br - ci * bi; Bim[n * 16 + c] = cr * bi + ci * br;
    }
  }
  for (int idx = tid; idx < 33 * 64; idx += NTHR) {
    const int m = idx >> 6, n = idx & 63;
    const float lr = p.lam_re[lg * 64 + n], li = p.lam_im[lg * 64 + n], dt = expf(p.log_dt[lg]);
    const float mg = expf(lr * dt * (float)m), ang = li * dt * (float)m;
    Apr[idx] = mg * cosf(ang); Api[idx] = mg * sinf(ang);
    if (m == 32) { P_AL[(lg * 64 + n) * 2 + 0] = Apr[idx]; P_AL[(lg * 64 + n) * 2 + 1] = Api[idx]; }
  }
  for (int idx = tid; idx < 1024; idx += NTHR) { Cre[idx] = p.c_re[lg * 1024 + idx]; Cim[idx] = p.c_im[lg * 1024 + idx]; }
  __syncthreads();
  for (int e = tid; e < 8192; e += NTHR) {
    const int m = e >> 8, c = (e >> 4) & 15, c2 = e & 15;
    float s = 0.f;
    for (int n = 0; n < 64; ++n) {
      const float ar = Apr[m * 64 + n], ai = Api[m * 64 + n], br = Bre[n * 16 + c2], bi = Bim[n * 16 + c2];
      const float wr = ar * br - ai * bi, wi = ar * bi + ai * br;
      s += Cre[c * 64 + n] * wr - Cim[c * 64 + n] * wi;
    }
    Kt[e] = s;
  }
  __syncthreads();
  bf16_t* TMg = P_TM + (size_t)lg * 512 * 640;
  {
    const int s = tid >> 4, c2 = tid & 15;
    for (int row = 0; row < 512; ++row) {
      const int j = row >> 4, c = row & 15;
      const float v = (s <= j) ? Kt[((j - s) << 8) + (c << 4) + c2] : 0.f;
      TMg[row * 640 + tid] = f2bf(v);
    }
  }
  for (int idx = tid; idx < 512 * 128; idx += NTHR) {
    const int row = idx >> 7, kk = idx & 127, j = row >> 4, c = row & 15, n = kk & 63, im = kk >> 6;
    const float ar = Apr[(j + 1) * 64 + n], ai = Api[(j + 1) * 64 + n], cr = Cre[c * 64 + n], ci = Cim[c * 64 + n];
    TMg[row * 640 + 512 + kk] = f2bf(im ? -(cr * ai + ci * ar) : (cr * ar - ci * ai));
  }
  bf16_t* Pg = P_PS + (size_t)lg * 128 * 512;
  for (int e = tid; e < 128 * 512; e += NTHR) {
    const int row = e >> 9, k = e & 511, n = row & 63, s = k >> 4, c2 = k & 15, m = 31 - s;
    const float ar = Apr[m * 64 + n], ai = Api[m * 64 + n], br = Bre[n * 16 + c2], bi = Bim[n * 16 + c2];
    Pg[e] = f2bf(row < 64 ? (ar * br - ai * bi) : (ar * bi + ai * br));
  }
  __syncthreads();
}

DI void prologue(const Params& p, char* smem) {
  const int tid = opq((int)threadIdx.x), bid = blockIdx.x, nb = gridDim.x;
  constexpr int T_WIN = 16 * 154;
  constexpr int T_WB = 8 * 16;
  constexpr int T_WO = 16 * 16;
  constexpr int T_GL = 8 * 8;
  constexpr int NT_ALL = 2 * T_WIN + 8 * T_WB + 2 * T_WO + 2 * T_GL + 32;
  float* tbuf = (float*)smem;
  constexpr int NT_HEAD = 192 * 20;
  const bool s5wg = (bid < 64) && (nb > 64);
  if (s5wg) s5_precompute(p, bid >> 5, bid & 31, smem);
  for (int it = (s5wg ? NT_HEAD + bid : (nb > 64 ? bid - 64 : bid)); it < NT_ALL; ) {
    int t = it;
    if (nb > 64) it += (it < NT_HEAD) ? (nb - 64) : nb; else it += nb;
    if (nb > 64 && t < NT_HEAD && it >= NT_HEAD) it = NT_HEAD + bid;
    if (t < 2 * T_WIN) {
      const int l = t / T_WIN, tt = t % T_WIN, kt = tt / 154, nt = tt % 154;
      transpose_tile(p.w_in + (size_t)l * DM * INW, INW, kt * 64, nt * 64, true, p.ng + l * DM, P_WinT + (size_t)l * ZW * DM, DM, tbuf);
      continue;
    }
    t -= 2 * T_WIN;
    if (t < 8 * T_WB) {
      const int lb = t / T_WB, tt = t % T_WB, kt = tt / 16, nt = tt % 16;
      transpose_tile(p.w_br + (size_t)lb * 512 * DM, DM, kt * 64, nt * 64, false, nullptr, P_WbT + (size_t)lb * DM * 512, 512, tbuf);
      continue;
    }
    t -= 8 * T_WB;
    if (t < 2 * T_WO) {
      const int l = t / T_WO, tt = t % T_WO, kt = tt / 16, nt = tt % 16;
      transpose_tile(p.w_out + (size_t)l * DM * DM, DM, kt * 64, nt * 64, false, nullptr, P_WoutT + (size_t)l * DM * DM, DM, tbuf);
      continue;
    }
    t -= 2 * T_WO;
    if (t < 2 * T_GL) {
      const int l = t / T_GL, tt = t % T_GL, kt = tt / 8, nt = tt % 8;
      transpose_tile(p.gluw + (size_t)l * 512 * 512, 512, kt * 64, nt * 64, false, nullptr, P_gluT + (size_t)l * 512 * 512, 512, tbuf);
      continue;
    }
    t -= 2 * T_GL;
    {
      const int which = t >> 4, lk = t & 15;
      transpose_tile((which ? p.wx : p.wa) + (size_t)lk * 4096, 64, 0, 0, false, nullptr, (which ? P_wxT : P_waT) + (size_t)lk * 4096, 64, tbuf);
    }
  }
  {
    const int lane = tid & 63, gw = bid * 8 + (tid >> 6), ngw = nb * 8;
    for (int row = gw; row < NROWS; row += ngw) {
      const float* src = nullptr;
      if (row < MROW0) src = p.x + (size_t)row * DM;
      else { const int j = row - MROW0; if (j >= 16 && j < 32) src = p.meta + (size_t)(j - 16) * DM; }
      float s = 0.f;
#pragma unroll
      for (int q = 0; q < 4; ++q) {
        f32x4 v = {0.f, 0.f, 0.f, 0.f};
        if (src) v = __builtin_nontemporal_load((const f32x4*)(src + q * 256 + lane * 4));
        s += v[0] * v[0] + v[1] * v[1] + v[2] * v[2] + v[3] * v[3];
        u32x2 o; o[0] = pk2(v[0], v[1]); o[1] = pk2(v[2], v[3]);
        *(u32x2*)(P_hb + (size_t)row * DM + q * 256 + lane * 4) = o;
        if (row >= MROW0) *(f32x4*)(P_hmeta + (size_t)(row - MROW0) * DM + q * 256 + lane * 4) = v;
      }
#pragma unroll
      for (int o = 1; o < 64; o <<= 1) s += __shfl_xor(s, o);
      if (lane == 0) { P_ss[row] = s; P_ss[NROWS + row] = 0.f; P_ss[2 * NROWS + row] = 0.f; }
    }
  }
  if (nb <= 64) for (int it = bid; it < 64; it += nb) s5_precompute(p, it >> 5, it & 31, smem);
}

struct UnitD {
  const bf16_t* z; const bf16_t* halo; bf16_t* ys;
  bf16_t *kvA, *kvB; const bf16_t *sA, *sB; float *decA, *decB;
  bf16_t *hloc, *cumA; float *cha, *chh; const float* cin;
  int pad, meta, uu;
};
DI UnitD make_unit(const Params& p, int uu) {
  UnitD u;
  if (uu < NUNIT) {
    const int bl = uu / NCH, c = uu % NCH; const size_t rb = (size_t)bl * SEQ + c * 32;
    u.z = P_zg + rb * ZW; u.halo = c > 0 ? (u.z - 3 * ZW) : (P_zm + 29 * ZW); u.ys = P_ysg + rb * 2048;
    u.kvA = (bf16_t*)P_kvA + (size_t)uu * 32768; u.kvB = (bf16_t*)P_kvB + (size_t)uu * 65536;
    u.sA = (const bf16_t*)P_kvA + (size_t)(NUNIT + uu) * 32768; u.sB = (const bf16_t*)P_kvB + (size_t)(NUNIT + uu) * 65536; u.decA = P_decA + uu * 256; u.decB = P_decB + uu * 512;
    u.hloc = P_hloc + rb * 512; u.cumA = P_cumA + rb * 512; u.cha = P_cha + uu * 512; u.chh = P_chh + uu * 512; u.cin = P_cin + uu * 512;
    u.pad = 0; u.meta = 0; u.uu = uu;
  } else {
    u.z = P_zm; u.halo = nullptr; u.ys = P_ysm; u.kvA = (bf16_t*)P_kvAm; u.kvB = (bf16_t*)P_kvBm; u.sA = nullptr; u.sB = nullptr; u.decA = nullptr; u.decB = nullptr;
    u.hloc = P_hlocm; u.cumA = P_cumAm; u.cha = nullptr; u.chh = P_chhm; u.cin = nullptr; u.pad = 16; u.meta = 1; u.uu = 0;
  }
  return u;
}

template <bool IS_GLA>
DI void gcum_build(const Params& p, const UnitD& u, int l, int half, float* Gs, float* lrs) {
  const int tid = opq((int)threadIdx.x);
  const int d = tid & 255, jh = tid >> 8;
  if (IS_GLA) {
    { const int j = tid >> 4, i = tid & 15; lrs[tid] = bf2f(u.z[(size_t)j * ZW + ZC_LR + i]); }
    __syncthreads();
    float wv[16];
#pragma unroll
    for (int i = 0; i < 16; ++i) wv[i] = p.w_lr[(l * 16 + i) * 256 + d];
    const float b = p.b_lr[l * 256 + d];
#pragma unroll 4
    for (int jj = 0; jj < 16; ++jj) {
      const int j = jh * 16 + jj;
      float a = b;
#pragma unroll
      for (int i = 0; i < 16; ++i) a += lrs[j * 16 + i] * wv[i];
      Gs[j * 256 + d] = (j < u.pad) ? 0.f : logsigmoidf_(a) * (1.f / 16.f);
    }
  } else {
    const int dg = half * 256 + d;
    const float lb = (l == 0) ? 0.f : sigmoidf_(p.lbl[512 + dg] - p.lbl[dg]);
    bf16_t raw[16];
#pragma unroll
    for (int jj = 0; jj < 16; ++jj) raw[jj] = u.z[(size_t)(jh * 16 + jj) * ZW + ZC_HF + dg];
#pragma unroll
    for (int jj = 0; jj < 16; ++jj) {
      const int j = jh * 16 + jj;
      const float f = lb + (1.f - lb) * sigmoidf_(bf2f(raw[jj]));
      Gs[j * 256 + d] = (j < u.pad) ? 0.f : __logf(f);
    }
  }
  __syncthreads();
  {
    const int dd = tid & 255, sg = tid >> 8;
    float v[16], base = 0.f;
    if (sg == 1) {
#pragma unroll
      for (int j = 0; j < 16; ++j) base += Gs[j * 256 + dd];
    }
#pragma unroll
    for (int j = 0; j < 16; ++j) v[j] = Gs[(sg * 16 + j) * 256 + dd];
    __syncthreads();
    float run = base;
#pragma unroll
    for (int j = 0; j < 16; ++j) { run += v[j]; Gs[(sg * 16 + j) * 256 + dd] = run; }
  }
  __syncthreads();
}

template <bool IS_GLA>
DI float kval_raw(bf16_t raw, float lb) {
  if (IS_GLA) return bf2f(raw);
  return 1.f - (lb + (1.f - lb) * sigmoidf_(bf2f(raw)));
}
template <bool IS_GLA>
DI float kval_of(const Params& p, const UnitD& u, int l, int half, int j, int d) {
  if (IS_GLA) return bf2f(u.z[(size_t)j * ZW + ZC_GK + d]);
  const int dg = half * 256 + d;
  const float lb = (l == 0) ? 0.f : sigmoidf_(p.lbl[512 + dg] - p.lbl[dg]);
  const float xv = bf2f(u.z[(size_t)j * ZW + ZC_HF + dg]);
  return 1.f - (lb + (1.f - lb) * sigmoidf_(xv));
}

template <bool IS_GLA>
DI bf16_t* qk_block(const Params& p, const UnitD& u, int half) {
  if (u.meta) return P_qkm + (IS_GLA ? 0 : (1 + half)) * 16384;
  if (IS_GLA) return P_qkA + (size_t)u.uu * 16384;
  return P_mgd + ((size_t)u.uu * 2 + half) * 16384;
}

template <bool IS_GLA>
DI void gla_local(const Params& p, const UnitD& u, int l, int half, char* smem) {
  constexpr int NH = IS_GLA ? 4 : 2, DK = IS_GLA ? 64 : 128, NV = NH * 128, DKT = DK / 32;
  float* Gs = (float*)smem; float* lrs = (float*)(smem + 32768);
  bf16_t* kT = (bf16_t*)(smem + 34816); bf16_t* vT = (bf16_t*)(smem + 55296);
  const int tid = opq((int)threadIdx.x), lane = tid & 63, w = tid >> 6, r = lane & 31, h = lane >> 5;
  gcum_build<IS_GLA>(p, u, l, half, Gs, lrs);
  if (!u.meta && tid < 256) {
    const float dv = __expf(Gs[31 * 256 + tid]);
    if (IS_GLA) u.decA[tid] = dv; else u.decB[half * 256 + tid] = dv;
  }
  {
    const int d = tid & 255, jb = tid >> 8;
    const int kcol = IS_GLA ? (ZC_GK + d) : (ZC_HF + half * 256 + d);
    float lb = 0.f;
    if (!IS_GLA && l != 0) lb = sigmoidf_(p.lbl[512 + half * 256 + d] - p.lbl[half * 256 + d]);
    const int qcol = IS_GLA ? (ZC_GQ + d) : (ZC_HQ + half * 256 + d);
    const float qscale = IS_GLA ? 0.125f : 1.f;
    bf16_t raw[16], rawq[16];
#pragma unroll
    for (int it = 0; it < 16; ++it) { raw[it] = u.z[(size_t)(jb * 16 + it) * ZW + kcol]; rawq[it] = u.z[(size_t)(jb * 16 + it) * ZW + qcol]; }
    const float gl = Gs[31 * 256 + d];
    bf16_t* QL = (bf16_t*)(smem + 96256); bf16_t* KL = (bf16_t*)(smem + 113152);
    float kend[16];
#pragma unroll
    for (int it = 0; it < 16; ++it) {
      const int j = jb * 16 + it;
      float kv = 0.f, qv = 0.f, kiv = 0.f;
      if (j >= u.pad) {
        const float g = Gs[j * 256 + d], kk = kval_raw<IS_GLA>(raw[it], lb);
        kv = kk * __expf(gl - g);
        qv = bf2f(rawq[it]) * qscale * __expf(g);
        kiv = kk * __expf(-g);
      }
      kend[it] = kv;
      QL[j * 264 + d] = f2bf(qv); KL[j * 264 + d] = f2bf(kiv);
    }
    u32x4 k0, k1;
#pragma unroll
    for (int e = 0; e < 4; ++e) { k0[e] = pk2(kend[2 * e], kend[2 * e + 1]); k1[e] = pk2(kend[8 + 2 * e], kend[8 + 2 * e + 1]); }
    *(u32x4*)(kT + d * 40 + jb * 16) = k0; *(u32x4*)(kT + d * 40 + jb * 16 + 8) = k1;
  }
  const int vcol = IS_GLA ? ZC_GV : (ZC_HI + half * 256);
  {
    constexpr int NBATCH = NV / 256;
    const int v = tid % NV, jbase = (tid / NV) * 16;
#pragma unroll 1
    for (int bb = 0; bb < NBATCH; ++bb) {
      const int j0 = jbase + bb * 16;
      bf16_t raw[16];
#pragma unroll
      for (int i = 0; i < 16; ++i) raw[i] = u.z[(size_t)(j0 + i) * ZW + vcol + v];
      u32x4 w0, w1;
#pragma unroll
      for (int e = 0; e < 4; ++e) {
        const unsigned a0 = (j0 + 2 * e >= u.pad) ? raw[2 * e] : 0u, a1 = (j0 + 2 * e + 1 >= u.pad) ? raw[2 * e + 1] : 0u;
        const unsigned b0 = (j0 + 8 + 2 * e >= u.pad) ? raw[8 + 2 * e] : 0u, b1 = (j0 + 8 + 2 * e + 1 >= u.pad) ? raw[8 + 2 * e + 1] : 0u;
        w0[e] = a0 | (a1 << 16); w1[e] = b0 | (b1 << 16);
      }
      *(u32x4*)(vT + v * 40 + j0) = w0; *(u32x4*)(vT + v * 40 + j0 + 8) = w1;
    }
  }
  __syncthreads();
  {
    bf16_t* qkb = qk_block<IS_GLA>(p, u, half);
    const bf16_t* QL = (const bf16_t*)(smem + 96256); const bf16_t* KL = (const bf16_t*)(smem + 113152);
#pragma unroll
    for (int uu2 = 0; uu2 < 2; ++uu2) {
      const int c = tid + NTHR * uu2, row = c >> 5, chk = c & 31;
      *(u32x4*)(qkb + c * 8) = *(const u32x4*)(QL + row * 264 + chk * 8);
      *(u32x4*)(qkb + 8192 + c * 8) = *(const u32x4*)(KL + row * 264 + chk * 8);
    }
  }
  bf16_t* kvbase = IS_GLA ? u.kvA : (u.kvB + (size_t)half * 2 * 128 * 128);
#pragma unroll 1
  for (int tu = 0; tu < 4; ++tu) {
    const int tt = w * 4 + tu;
    const int dkt = tt % DKT, vt = (tt / DKT) % 4, hd = tt / (4 * DKT);
    f32x16 acc = zero16();
#pragma unroll
    for (int ks = 0; ks < 2; ++ks) {
      const bf16x8 a = *(const bf16x8*)(vT + (hd * 128 + vt * 32 + r) * 40 + ks * 16 + 8 * h);
      const bf16x8 b = *(const bf16x8*)(kT + (hd * DK + dkt * 32 + r) * 40 + ks * 16 + 8 * h);
      acc = MFMA32(b, a, acc);
    }
    bf16_t* dst = kvbase + ((size_t)hd * 128 + vt * 32 + r) * DK + dkt * 32 + 4 * h;
#pragma unroll
    for (int q = 0; q < 4; ++q) {
      u32x2 o; o[0] = pk2(acc[4 * q], acc[4 * q + 1]); o[1] = pk2(acc[4 * q + 2], acc[4 * q + 3]);
      *(u32x2*)(dst + 8 * q) = o;
    }
  }
  __syncthreads();
}

template <bool IS_GLA>
DI void gla_out(const Params& p, const UnitD& u, int l, int half, char* smem) {
  constexpr int NH = IS_GLA ? 4 : 2, DK = IS_GLA ? 64 : 128, NV = NH * 128, WPH = 8 / NH, VTP = 4 / WPH, KS = DK / 16;
  float* Gs = (float*)smem; float* lrs = (float*)(smem + 32768);
  bf16_t* qd = (bf16_t*)(smem + 34816); bf16_t* ki = (bf16_t*)(smem + 51712); bf16_t* vT = (bf16_t*)(smem + 68608);
  float* part = (float*)(smem + 109568);
  const int tid = opq((int)threadIdx.x), lane = tid & 63, w = tid >> 6, r = lane & 31, h = lane >> 5;
  (void)Gs; (void)lrs;
  bf16_t* GT = (bf16_t*)(smem + 112640);
  {
    const int gcol0 = IS_GLA ? ZC_GG : (ZC_HG + half * 256);
    constexpr int CPR = NV / 8, NCK = 32 * CPR / NTHR;
    u32x4 gt[NCK];
#pragma unroll
    for (int uu2 = 0; uu2 < NCK; ++uu2) { const int c = tid + NTHR * uu2, row = c / CPR, chk = c % CPR; gt[uu2] = *(const u32x4*)(u.z + (size_t)row * ZW + gcol0 + chk * 8); }
#pragma unroll
    for (int uu2 = 0; uu2 < NCK; ++uu2) { const int c = tid + NTHR * uu2, row = c / CPR, chk = c % CPR; *(u32x4*)(GT + row * (NV + 8) + chk * 8) = gt[uu2]; }
  }
  {
    const bf16_t* qkb = qk_block<IS_GLA>(p, u, half);
    u32x4 t0[2], t1[2];
#pragma unroll
    for (int uu2 = 0; uu2 < 2; ++uu2) { const int q = tid + NTHR * uu2; t0[uu2] = *(const u32x4*)(qkb + q * 8); t1[uu2] = *(const u32x4*)(qkb + 8192 + q * 8); }
#pragma unroll
    for (int uu2 = 0; uu2 < 2; ++uu2) { const int q = tid + NTHR * uu2, row = q >> 5, ch = q & 31; *(u32x4*)(qd + row * 264 + ch * 8) = t0[uu2]; *(u32x4*)(ki + row * 264 + ch * 8) = t1[uu2]; }
  }
  const int vcol = IS_GLA ? ZC_GV : (ZC_HI + half * 256);
  {
    constexpr int NBATCH = NV / 256;
    const int v = tid % NV, jbase = (tid / NV) * 16;
#pragma unroll 1
    for (int bb = 0; bb < NBATCH; ++bb) {
      const int j0 = jbase + bb * 16;
      bf16_t raw[16];
#pragma unroll
      for (int i = 0; i < 16; ++i) raw[i] = u.z[(size_t)(j0 + i) * ZW + vcol + v];
      u32x4 w0, w1;
#pragma unroll
      for (int e = 0; e < 4; ++e) {
        const unsigned a0 = (j0 + 2 * e >= u.pad) ? raw[2 * e] : 0u, a1 = (j0 + 2 * e + 1 >= u.pad) ? raw[2 * e + 1] : 0u;
        const unsigned b0 = (j0 + 8 + 2 * e >= u.pad) ? raw[8 + 2 * e] : 0u, b1 = (j0 + 8 + 2 * e + 1 >= u.pad) ? raw[8 + 2 * e + 1] : 0u;
        w0[e] = a0 | (a1 << 16); w1[e] = b0 | (b1 << 16);
      }
      *(u32x4*)(vT + v * 40 + j0) = w0; *(u32x4*)(vT + v * 40 + j0 + 8) = w1;
    }
  }
  __syncthreads();
  const int hd = w / WPH, sub = w % WPH;
  const int hdg = IS_GLA ? hd : (half * 2 + hd);
  f32x16 X = zero16();
#pragma unroll
  for (int ks = 0; ks < KS; ++ks) {
    const bf16x8 a = *(const bf16x8*)(ki + r * 264 + hd * DK + ks * 16 + 8 * h);
    const bf16x8 b = *(const bf16x8*)(qd + r * 264 + hd * DK + ks * 16 + 8 * h);
    X = MFMA32(a, b, X);
  }
#pragma unroll
  for (int reg = 0; reg < 16; ++reg) if (crow(reg, h) > r) X[reg] = 0.f;
  bf16x8 xs[2];
  xs[0] = pack8(X[0], X[1], X[2], X[3], X[4], X[5], X[6], X[7]);
  xs[1] = pack8(X[8], X[9], X[10], X[11], X[12], X[13], X[14], X[15]);
  f32x16 o[VTP];
  const bf16_t* Sbase = (IS_GLA ? u.sA : u.sB) + (size_t)hdg * 128 * DK;
#pragma unroll
  for (int vt = 0; vt < VTP; ++vt) {
    const int vg = sub * VTP + vt;
    o[vt] = zero16();
#pragma unroll
    for (int st = 0; st < 2; ++st) {
      const bf16x4 lo = *(const bf16x4*)(vT + (hd * 128 + vg * 32 + r) * 40 + 16 * st + 4 * h);
      const bf16x4 hi = *(const bf16x4*)(vT + (hd * 128 + vg * 32 + r) * 40 + 16 * st + 8 + 4 * h);
      const bf16x8 pb = __builtin_shufflevector(lo, hi, 0, 1, 2, 3, 4, 5, 6, 7);
      o[vt] = MFMA32(xs[st], pb, o[vt]);
    }
    if (!u.meta) {
      const bf16_t* Sp = Sbase + (size_t)(vg * 32 + r) * DK + 8 * h;
      bf16x8 sb[KS];
#pragma unroll
      for (int ks = 0; ks < KS; ++ks) sb[ks] = *(const bf16x8*)(Sp + ks * 16);
#pragma unroll
      for (int ks = 0; ks < KS; ++ks) {
        const bf16x8 a = *(const bf16x8*)(qd + r * 264 + hd * DK + ks * 16 + 8 * h);
        o[vt] = MFMA32(a, sb[ks], o[vt]);
      }
    }
  }
#pragma unroll
  for (int reg = 0; reg < 16; ++reg) {
    float s = 0.f;
#pragma unroll
    for (int vt = 0; vt < VTP; ++vt) s += o[vt][reg] * o[vt][reg];
#pragma unroll
    for (int off = 1; off < 32; off <<= 1) s += __shfl_xor(s, off);
    if (r == 0) part[w * 32 + crow(reg, h)] = s;
  }
  __syncthreads();
  const float* gn = (IS_GLA ? p.gnorm : p.hnorm) + (l * 4 + hdg) * 128;
  const int yoff = IS_GLA ? 0 : (512 + half * 256);
#pragma unroll
  for (int reg = 0; reg < 16; ++reg) {
    const int c = crow(reg, h);
    float tot = 0.f;
#pragma unroll
    for (int ww = 0; ww < WPH; ++ww) tot += part[(hd * WPH + ww) * 32 + c];
    const float rsq = rsqrtf(tot * (1.f / 128.f) + EPS);
#pragma unroll
    for (int vt = 0; vt < VTP; ++vt) {
      const int v = (sub * VTP + vt) * 32 + r;
      bf16_t* gp = GT + c * (NV + 8) + hd * 128 + v;
      const float gate = bf2f(*gp);
      *gp = f2bf(o[vt][reg] * rsq * gn[v] * siluf_(gate));
    }
  }
  __syncthreads();
  {
    constexpr int CPR = NV / 8, NCK = 32 * CPR / NTHR;
#pragma unroll
    for (int uu2 = 0; uu2 < NCK; ++uu2) {
      const int c = tid + NTHR * uu2, row = c / CPR, chk = c % CPR;
      *(u32x4*)(u.ys + (size_t)row * 2048 + yoff + chk * 8) = *(const u32x4*)(GT + row * (NV + 8) + chk * 8);
    }
  }
  __syncthreads();
}

DI void lru_local(const Params& p, const UnitD& u, int l, char* smem) {
  float* XC = (float*)smem;
  bf16_t* XCb = (bf16_t*)(smem + 33280);
  float* LA = (float*)(smem + 50176);
  const int tid = opq((int)threadIdx.x), lane = tid & 63, w = tid >> 6, r = lane & 31, h = lane >> 5;
#pragma unroll 1
  for (int hf = 0; hf < 2; ++hf) {
    {
      const int n = tid & 255, jh = tid >> 8, ch = hf * 256 + n, j0 = jh * 16;
      const float w0 = p.convw[(l * 4 + 0) * 512 + ch], w1 = p.convw[(l * 4 + 1) * 512 + ch], w2 = p.convw[(l * 4 + 2) * 512 + ch],
                  w3 = p.convw[(l * 4 + 3) * 512 + ch], cb = p.convb[l * 512 + ch];
      bf16_t xr[19];
#pragma unroll
      for (int i = 0; i < 19; ++i) {
        if (i < 3 && j0 == 0) xr[i] = u.halo ? u.halo[(size_t)i * ZW + ZC_LX + ch] : (bf16_t)0;
        else xr[i] = u.z[(size_t)(j0 - 3 + i) * ZW + ZC_LX + ch];
      }
      float x3 = bf2f(xr[0]), x2 = bf2f(xr[1]), x1 = bf2f(xr[2]);
#pragma unroll
      for (int jj = 0; jj < 16; ++jj) {
        const int j = j0 + jj;
        const float x0 = bf2f(xr[3 + jj]);
        const float xc = cb + w0 * x0 + w1 * x1 + w2 * x2 + w3 * x3;
        XC[j * 260 + n] = xc; XCb[j * 264 + n] = f2bf(xc);
        x3 = x2; x2 = x1; x1 = x0;
      }
    }
    __syncthreads();
    {
      const int blk = w >> 1, nt = w & 1, blkg = hf * 4 + blk;
      const bf16_t* wa = P_waT + ((size_t)(l * 8 + blkg) * 64 + nt * 32 + r) * 64 + 8 * h;
      const bf16_t* wx = P_wxT + ((size_t)(l * 8 + blkg) * 64 + nt * 32 + r) * 64 + 8 * h;
      f32x16 aa = zero16(), ax = zero16();
#pragma unroll
      for (int ks = 0; ks < 4; ++ks) {
        const bf16x8 a1 = *(const bf16x8*)(wa + ks * 16), a2 = *(const bf16x8*)(wx + ks * 16);
        const bf16x8 b = *(const bf16x8*)(XCb + r * 264 + blk * 64 + ks * 16 + 8 * h);
        aa = MFMA32(a1, b, aa); ax = MFMA32(a2, b, ax);
      }
#pragma unroll
      for (int q = 0; q < 4; ++q) {
        const int nn = blk * 64 + nt * 32 + 8 * q + 4 * h, chg = hf * 256 + nn;
        f32x4 xc = *(const f32x4*)(XC + r * 260 + nn);
        f32x4 av, iv;
#pragma unroll
        for (int i = 0; i < 4; ++i) {
          const float rr = sigmoidf_(aa[4 * q + i] + p.ba[l * 512 + chg + i]);
          const float ig = sigmoidf_(ax[4 * q + i] + p.bx[l * 512 + chg + i]);
          const float la = -8.f * rr * softplusf_(-p.lam[l * 512 + chg + i]);
          float a = __expf(la), inp = __builtin_amdgcn_sqrtf(fmaxf(1.f - __expf(2.f * la), 0.f)) * ig * xc[i];
          if (r < u.pad) { a = 1.f; inp = 0.f; }
          av[i] = a; iv[i] = inp;
        }
        *(f32x4*)(LA + r * 260 + nn) = av; *(f32x4*)(XC + r * 260 + nn) = iv;
      }
    }
    __syncthreads();
    if (tid < 256) {
      const int n = tid, ch = hf * 256 + n;
      float hh = 0.f, A = 1.f;
      for (int j = 0; j < 32; ++j) {
        const float a = LA[j * 260 + n], xv = XC[j * 260 + n];
        hh = a * hh + xv; A *= a;
        u.hloc[(size_t)j * 512 + ch] = f2bf(hh); u.cumA[(size_t)j * 512 + ch] = f2bf(A);
      }
      if (u.cha) u.cha[ch] = A;
      u.chh[ch] = hh;
    }
    __syncthreads();
  }
}

DI void lru_out(const Params& p, const UnitD& u, char* smem) {
  const int tid = opq((int)threadIdx.x);
  u32x4 hv[4], av[4], gv[4];
#pragma unroll
  for (int it = 0; it < 4; ++it) {
    const int idx = tid + NTHR * it, j = idx >> 6, c8 = idx & 63;
    hv[it] = *(const u32x4*)(u.hloc + (size_t)j * 512 + c8 * 8);
    av[it] = *(const u32x4*)(u.cumA + (size_t)j * 512 + c8 * 8);
    gv[it] = *(const u32x4*)(u.z + (size_t)j * ZW + ZC_LG + c8 * 8);
  }
#pragma unroll
  for (int it = 0; it < 4; ++it) {
    const int idx = tid + NTHR * it, j = idx >> 6, c8 = idx & 63;
    float ci[8];
#pragma unroll
    for (int e = 0; e < 8; ++e) ci[e] = u.cin ? u.cin[c8 * 8 + e] : 0.f;
    u32x4 o;
#pragma unroll
    for (int e = 0; e < 4; ++e) {
      float r2[2];
#pragma unroll
      for (int k = 0; k < 2; ++k) {
        const float hh = bf2f((bf16_t)(hv[it][e] >> (16 * k))), aa = bf2f((bf16_t)(av[it][e] >> (16 * k))), gt = bf2f((bf16_t)(gv[it][e] >> (16 * k)));
        r2[k] = (hh + aa * ci[2 * e + k]) * siluf_(gt);
      }
      o[e] = pk2(r2[0], r2[1]);
    }
    *(u32x4*)(u.ys + (size_t)j * 2048 + 1536 + c8 * 8) = o;
  }
}

DI void s5_item(const Params& p, int l, int grp, int bl, int gs, char* smem) {
  bf16_t* Ub = (bf16_t*)smem;
  float* E = (float*)(smem + 41472);
  char* FT = smem + 110112;
  const int tid = opq((int)threadIdx.x), lane = tid & 63, w = tid >> 6, r = lane & 31, h = lane >> 5;
  const int lg = l * 32 + gs;
  const bf16_t* Pg = P_PS + (size_t)lg * 128 * 512;
  const bf16_t* TMg = P_TM + (size_t)lg * 512 * 640;
  const bool wmeta = (grp == 0 && bl == 0);
  auto load_U = [&](int ut) {
#pragma unroll
    for (int it = 0; it < 4; ++it) {
      const int idx = tid + NTHR * it, m = idx >> 6, rem = idx & 63, s = rem >> 1, hv = rem & 1, uu = ut * 32 + m;
      u32x4 val = {0u, 0u, 0u, 0u};
      if (uu <= NCH) {
        const bf16_t* zr = (uu == 0) ? P_zm : (P_zg + ((size_t)bl * SEQ + (uu - 1) * 32) * ZW);
        val = *(const u32x4*)(zr + (size_t)s * ZW + ZC_SU + gs * 16 + hv * 8);
      }
      *(u32x4*)(Ub + m * 648 + s * 16 + hv * 8) = val;
    }
  };
  for (int idx = tid; idx < 33 * 64; idx += NTHR) {
    const int di = idx >> 6, ln = idx & 63, d = di - 1, rt0 = (d + (d & 1)) >> 1, ks0 = d & 1;
    *(u32x4*)(FT + di * 1024 + ln * 16) = *(const u32x4*)(TMg + (size_t)(rt0 * 32 + (ln & 31)) * 640 + ks0 * 16 + 8 * (ln >> 5));
  }
#pragma unroll 1
  for (int ut = 0; ut < 5; ++ut) {
    load_U(ut);
    __syncthreads();
    const int nt = w & 3, kh = w >> 2;
    f32x16 acc = zero16();
#pragma unroll 8
    for (int kk = 0; kk < 16; ++kk) {
      const int ks = kh * 16 + kk;
      const bf16x8 a = *(const bf16x8*)(Pg + (size_t)(nt * 32 + r) * 512 + ks * 16 + 8 * h);
      const bf16x8 b = *(const bf16x8*)(Ub + r * 648 + ks * 16 + 8 * h);
      acc = MFMA32(a, b, acc);
    }
    float* er = E + (ut * 32 + r) * 132 + nt * 32 + 4 * h;
    const bool uok = (ut * 32 + r) < 130;
    if (kh == 1 && uok) {
#pragma unroll
      for (int q = 0; q < 4; ++q) { f32x4 v = {acc[4 * q], acc[4 * q + 1], acc[4 * q + 2], acc[4 * q + 3]}; *(f32x4*)(er + 8 * q) = v; }
    }
    __syncthreads();
    if (kh == 0 && uok) {
#pragma unroll
      for (int q = 0; q < 4; ++q) {
        f32x4 v = *(const f32x4*)(er + 8 * q);
        v[0] += acc[4 * q]; v[1] += acc[4 * q + 1]; v[2] += acc[4 * q + 2]; v[3] += acc[4 * q + 3];
        *(f32x4*)(er + 8 * q) = v;
      }
    }
    __syncthreads();
  }
  if (tid < 64) {
    const int n = tid;
    const float ar = P_AL[(lg * 64 + n) * 2], ai = P_AL[(lg * 64 + n) * 2 + 1];
    float hr = 0.f, hi = 0.f;
    for (int uu = 0; uu <= NCH; ++uu) {
      const float er = E[uu * 132 + n], ei = E[uu * 132 + 64 + n];
      E[uu * 132 + n] = hr; E[uu * 132 + 64 + n] = hi;
      const float nhr = ar * hr - ai * hi + er, nhi = ar * hi + ai * hr + ei;
      hr = nhr; hi = nhi;
    }
  }
  __syncthreads();
#pragma unroll 1
  for (int ut = 0; ut < 5; ++ut) {
    load_U(ut);
    for (int idx = tid; idx < 32 * 128; idx += NTHR) {
      const int m = idx >> 7, kk = idx & 127;
      Ub[m * 648 + 512 + kk] = ((ut * 32 + m) < 130) ? f2bf(E[(ut * 32 + m) * 132 + kk]) : (bf16_t)0;
    }
    __syncthreads();
    f32x16 acc0 = zero16(), acc1 = zero16();
    const bf16_t* a0p = TMg + (size_t)(w * 32 + r) * 640 + 8 * h;
    const bf16_t* a1p = TMg + (size_t)((15 - w) * 32 + r) * 640 + 8 * h;
    const bf16_t* bp = Ub + r * 648 + 8 * h;
    {
      const int n0 = 2 * w + 2;
      const char* f0 = FT + (2 * w + 1) * 1024 + lane * 16;
#pragma unroll 2
      for (int ks = 0; ks < n0; ++ks) acc0 = MFMA32(*(const bf16x8*)(f0 - ks * 1024), *(const bf16x8*)(bp + ks * 16), acc0);
      const int n1 = 32 - 2 * w;
      const char* f1 = FT + (2 * (15 - w) + 1) * 1024 + lane * 16;
#pragma unroll 2
      for (int ks = 0; ks < n1; ++ks) acc1 = MFMA32(*(const bf16x8*)(f1 - ks * 1024), *(const bf16x8*)(bp + ks * 16), acc1);
#pragma unroll
      for (int ks = 32; ks < 40; ++ks) {
        const bf16x8 b = *(const bf16x8*)(bp + ks * 16);
        acc0 = MFMA32(*(const bf16x8*)(a0p + ks * 16), b, acc0); acc1 = MFMA32(*(const bf16x8*)(a1p + ks * 16), b, acc1);
      }
    }
    const int uu = ut * 32 + r;
    if (uu <= NCH && (uu > 0 || wmeta)) {
      bf16_t* yrow = (uu == 0) ? P_ygm : (P_ygg + ((size_t)bl * SEQ + (uu - 1) * 32) * 512);
#pragma unroll
      for (int rr = 0; rr < 2; ++rr) {
        const int rt = rr ? (15 - w) : w;
#pragma unroll
        for (int q = 0; q < 4; ++q) {
          const int j = rt * 2 + (q >> 1), c = 8 * (q & 1) + 4 * h, ch = gs * 16 + c;
          float yv[4];
#pragma unroll
          for (int i = 0; i < 4; ++i) {
            const float av = rr ? acc1[4 * q + i] : acc0[4 * q + i];
            const float uv = bf2f(Ub[r * 648 + j * 16 + c + i]);
            yv[i] = geluf_(av + p.s5d[l * 512 + ch + i] * uv);
          }
          u32x2 o; o[0] = pk2(yv[0], yv[1]); o[1] = pk2(yv[2], yv[3]);
          *(u32x2*)(yrow + (size_t)j * 512 + ch) = o;
        }
      }
    }
    __syncthreads();
  }
}

DI void gemm1_small_tile(const Params& p, int l, const bf16_t* A, bf16_t* out, const float* ss, int nt, char* smem) {
  const int tid = opq((int)threadIdx.x), lane = tid & 63, w = tid >> 6, r = lane & 31, h = lane >> 5, wm = w & 3, wn = w >> 2;
  f32x16 acc[2][2];
#pragma unroll
  for (int i = 0; i < 2; ++i) for (int j = 0; j < 2; ++j) acc[i][j] = zero16();
  gemm_main(A, DM, P_WinT + ((size_t)l * ZW + nt * 128) * DM, DM, DM, smem, acc);
#pragma unroll
  for (int j = 0; j < 2; ++j) {
    const int m = wm * 64 + j * 32 + r;
    const float rs = rsqrtf(ss[m] * (1.f / DM) + EPS);
#pragma unroll
    for (int i = 0; i < 2; ++i)
#pragma unroll
      for (int q = 0; q < 4; ++q) {
        const int n = nt * 128 + wn * 64 + i * 32 + 8 * q + 4 * h;
        u32x2 o; o[0] = pk2(acc[i][j][4 * q] * rs, acc[i][j][4 * q + 1] * rs); o[1] = pk2(acc[i][j][4 * q + 2] * rs, acc[i][j][4 * q + 3] * rs);
        *(u32x2*)(out + (size_t)m * ZW + n) = o;
      }
  }
}

DI void phase_gemm1(const Params& p, int l, int g, char* smem) {
  const int tid = opq((int)threadIdx.x), lane = tid & 63, w = tid >> 6, r = lane & 31, h = lane >> 5;
  const int bid = blockIdx.x, nb = gridDim.x;
  constexpr int NBIG = 32 * 38;
  for (int t = bid; t < NBIG; t += nb) {
    const int mt = t & 31, nt2 = t >> 5;
    const bf16_t* A = P_hb + ((size_t)g * RG + mt * 256) * DM;
    bf16_t* out = P_zg + (size_t)mt * 256 * ZW;
    const float* ss = P_ss + l * NROWS + g * RG + mt * 256;
    f32x16 acc[2][4];
#pragma unroll
    for (int i = 0; i < 2; ++i) for (int j = 0; j < 4; ++j) acc[i][j] = zero16();
    gemm_main_256(A, DM, P_WinT + ((size_t)l * ZW + nt2 * 256) * DM, DM, DM, smem, acc);
    const int wm = w & 1, wn = w >> 1;
#pragma unroll
    for (int j = 0; j < 4; ++j) {
      const int m = wm * 128 + j * 32 + r;
      const float rs = rsqrtf(ss[m] * (1.f / DM) + EPS);
#pragma unroll
      for (int i = 0; i < 2; ++i)
#pragma unroll
        for (int q = 0; q < 4; ++q) {
          const int n = nt2 * 256 + wn * 64 + i * 32 + 8 * q + 4 * h;
          u32x2 o; o[0] = pk2(acc[i][j][4 * q] * rs, acc[i][j][4 * q + 1] * rs); o[1] = pk2(acc[i][j][4 * q + 2] * rs, acc[i][j][4 * q + 3] * rs);
          *(u32x2*)(out + (size_t)m * ZW + n) = o;
        }
    }
  }
  const int nsmall = 32 + (g == 0 ? 77 : 0);
  const int first = (nb > 192) ? 192 : 0, nw = nb - first;
  if (bid >= first) {
    for (int s = bid - first; s < nsmall; s += nw) {
      if (s < 32) gemm1_small_tile(p, l, P_hb + ((size_t)g * RG + s * 256) * DM, P_zg + (size_t)s * 256 * ZW, P_ss + l * NROWS + g * RG + s * 256, 76, smem);
      else gemm1_small_tile(p, l, P_hb + (size_t)MROW0 * DM, P_zm, P_ss + l * NROWS + MROW0, s - 32, smem);
    }
  }
}

DI int grab_item(unsigned* ctr, char* smem) {
  volatile int* slot = (volatile int*)(smem + LDS_BYTES - 16);
  __syncthreads();
  if (threadIdx.x == 0) *slot = (int)__hip_atomic_fetch_add(ctr, 1u, __ATOMIC_RELAXED, __HIP_MEMORY_SCOPE_AGENT);
  __syncthreads();
  return *slot;
}

DI void phase_local(const Params& p, int l, int g, char* smem) {
  unsigned* ctr = P_ctrl + 64 + ((l * NGRP + g) * 2 + 0) * 16;
  const int nun = NUNIT + (g == 0 ? 1 : 0);
  const int nitem = NB * 32 + nun * 4;
  for (;;) {
    const int it = grab_item(ctr, smem);
    if (it >= nitem) break;
    if (it < NB * 32) { s5_item(p, l, g, it >> 5, it & 31, smem); continue; }
    const int s = it - NB * 32;
    const int uu = s >> 2, ty = s & 3;
    const UnitD u = make_unit(p, uu);
    if (ty == 0) gla_local<true>(p, u, l, 0, smem);
    else if (ty == 1) gla_local<false>(p, u, l, 0, smem);
    else if (ty == 2) gla_local<false>(p, u, l, 1, smem);
    else lru_local(p, u, l, smem);
  }
}

DI void glu_tile(const Params& p, int l, int bid, char* smem) {
  const int tid = opq((int)threadIdx.x), lane = tid & 63, w = tid >> 6, r = lane & 31, h = lane >> 5, wm = w & 3, wn = w >> 2;
  {
    const bf16_t* A; const bf16_t* zz; bf16_t* ys; int nt;
    if (bid < 128) { const int mt = bid & 31; nt = bid >> 5; A = P_ygg + (size_t)mt * 256 * 512; zz = P_zg + (size_t)mt * 256 * ZW; ys = P_ysg + (size_t)mt * 256 * 2048; }
    else { nt = bid - 128; A = P_ygm; zz = P_zm; ys = P_ysm; }
    f32x16 acc[2][2];
#pragma unroll
    for (int i = 0; i < 2; ++i) for (int j = 0; j < 2; ++j) acc[i][j] = zero16();
    gemm_main(A, 512, P_gluT + ((size_t)l * 512 + nt * 128) * 512, 512, 512, smem, acc, bid >= 128);
#pragma unroll
    for (int j = 0; j < 2; ++j) {
      const int m = wm * 64 + j * 32 + r;
#pragma unroll
      for (int i = 0; i < 2; ++i)
#pragma unroll
        for (int q = 0; q < 4; ++q) {
          const int n = nt * 128 + wn * 64 + i * 32 + 8 * q + 4 * h;
          const u32x2 yv = *(const u32x2*)(A + (size_t)m * 512 + n);
          const u32x2 gv = *(const u32x2*)(zz + (size_t)m * ZW + ZC_SG + n);
          float o4[4];
#pragma unroll
          for (int e = 0; e < 4; ++e) {
            const float y = bf2f((bf16_t)(yv[e >> 1] >> (16 * (e & 1))));
            const float gt = bf2f((bf16_t)(gv[e >> 1] >> (16 * (e & 1))));
            o4[e] = y * sigmoidf_(acc[i][j][4 * q + e] + p.glub[l * 512 + n + e]) * siluf_(gt);
          }
          u32x2 o; o[0] = pk2(o4[0], o4[1]); o[1] = pk2(o4[2], o4[3]);
          *(u32x2*)(ys + (size_t)m * 2048 + 1024 + n) = o;
        }
    }
  }
}

DI void phase_scan_states(const Params& p, int l, int g) {
  const int tid = opq((int)threadIdx.x), bid = blockIdx.x;
  typedef float f32x2 __attribute__((ext_vector_type(2)));
  if (tid < 384) {
    const int e = bid * 384 + tid;
    const bf16_t* pk; bf16_t* ps; const float* dec; const bf16_t* init; size_t pstride; int dstride;
    if (e < 32768) {
      const int bl = e / 16384, rem = e % 16384, el = rem * 2, hd = el / 8192, dk = el % 64;
      pk = (const bf16_t*)P_kvA + (size_t)bl * NCH * 32768 + el; ps = (bf16_t*)P_kvA + (size_t)(NUNIT + bl * NCH) * 32768 + el; pstride = 32768;
      init = (const bf16_t*)P_kvAm + el;
      dec = P_decA + (size_t)bl * NCH * 256 + hd * 64 + dk; dstride = 256;
    } else {
      const int e2 = e - 32768, bl = e2 / 32768, rem = e2 % 32768, el = rem * 2, hd = el / 16384, dk = el % 128;
      pk = (const bf16_t*)P_kvB + (size_t)bl * NCH * 65536 + el; ps = (bf16_t*)P_kvB + (size_t)(NUNIT + bl * NCH) * 65536 + el; pstride = 65536;
      init = (const bf16_t*)P_kvBm + el;
      dec = P_decB + (size_t)bl * NCH * 512 + hd * 128 + dk; dstride = 512;
    }
    f32x2 s;
    { const unsigned iv = *(const unsigned*)init; s[0] = bf2f((bf16_t)iv); s[1] = bf2f((bf16_t)(iv >> 16)); }
#pragma unroll 1
    for (int c0 = 0; c0 < NCH; c0 += SCAN_U) {
      unsigned cur[SCAN_U]; f32x2 dd[SCAN_U];
#pragma unroll
      for (int i = 0; i < SCAN_U; ++i) { cur[i] = __builtin_nontemporal_load((const unsigned*)(pk + (size_t)(c0 + i) * pstride)); dd[i] = *(const f32x2*)(dec + (size_t)(c0 + i) * dstride); }
#pragma unroll
      for (int i = 0; i < SCAN_U; ++i) {
        *(unsigned*)(ps + (size_t)(c0 + i) * pstride) = pk2(s[0], s[1]);
        s[0] = dd[i][0] * s[0] + bf2f((bf16_t)cur[i]);
        s[1] = dd[i][1] * s[1] + bf2f((bf16_t)(cur[i] >> 16));
      }
    }
  } else if (bid < 8) {
    const int e = bid * 128 + (tid - 384), bl = e >> 9, n = e & 511;
    float carry = P_chhm[n];
#pragma unroll 8
    for (int c = 0; c < NCH; ++c) {
      const int ix = (bl * NCH + c) * 512 + n;
      const float a = P_cha[ix], hh = P_chh[ix];
      P_cin[ix] = carry;
      carry = a * carry + hh;
    }
  }
}

DI void phase_output(const Params& p, int l, int g, char* smem) {
  unsigned* ctr = P_ctrl + 64 + ((l * NGRP + g) * 2 + 1) * 16;
  const int nun = NUNIT + (g == 0 ? 1 : 0);
  const int nglu = 128 + (g == 0 ? 4 : 0);
  for (;;) {
    int s = grab_item(ctr, smem);
    if (s >= nglu + nun * 4) break;
    if (s < nglu) { glu_tile(p, l, s, smem); continue; }
    s -= nglu;
    const int ty = s / nun, uu = s % nun;
    const UnitD u = make_unit(p, uu);
    if (ty == 0) gla_out<true>(p, u, l, 0, smem);
    else if (ty == 1) gla_out<false>(p, u, l, 0, smem);
    else if (ty == 2) gla_out<false>(p, u, l, 1, smem);
    else lru_out(p, u, smem);
  }
}

DI void phase_gemm2(const Params& p, int l, int g, char* smem) {
  const int tid = opq((int)threadIdx.x), lane = tid & 63, w = tid >> 6, r = lane & 31, h = lane >> 5, wm = w & 3, wn = w >> 2;
  const int ntile = 256 + (g == 0 ? 8 : 0);
  for (int t = blockIdx.x; t < ntile; t += gridDim.x) {
    const bf16_t* A; const bf16_t* zz; bf16_t* out; int nt;
    if (t < 256) { const int mt = t & 31; nt = t >> 5; A = P_ysg + (size_t)mt * 256 * 2048; zz = P_zg + (size_t)mt * 256 * ZW; out = P_mgd + (size_t)mt * 256 * DM; }
    else { nt = t - 256; A = P_ysm; zz = P_zm; out = P_mgdm; }
    f32x16 macc[2][2];
#pragma unroll
    for (int i = 0; i < 2; ++i) for (int j = 0; j < 2; ++j) macc[i][j] = zero16();
#pragma unroll 1
    for (int nb = 0; nb < 4; ++nb) {
      f32x16 acc[2][2];
#pragma unroll
      for (int i = 0; i < 2; ++i) for (int j = 0; j < 2; ++j) acc[i][j] = zero16();
      gemm_main(A + nb * 512, 2048, P_WbT + (((size_t)l * 4 + nb) * DM + nt * 128) * 512, 512, 512, smem, acc, t >= 256, zz + ZC_MG + nb * 1024 + nt * 128, ZW);
#pragma unroll
      for (int j = 0; j < 2; ++j) {
        const int m = wm * 64 + j * 32 + r;
#pragma unroll
        for (int i = 0; i < 2; ++i)
#pragma unroll
          for (int q = 0; q < 4; ++q) {
            const char* grow = (m < 192) ? (smem + 2 * 49152 + m * 256) : (smem + 0 * 49152 + (m - 192) * 256);
            const u32x2 gv = *(const u32x2*)(grow + (((wn * 8 + i * 4 + q) ^ (m & 15)) << 4) + 8 * h);
#pragma unroll
            for (int e = 0; e < 4; ++e) {
              const float gt = bf2f((bf16_t)(gv[e >> 1] >> (16 * (e & 1))));
              macc[i][j][4 * q + e] += sigmoidf_(gt) * acc[i][j][4 * q + e];
            }
          }
      }
    }
#pragma unroll
    for (int j = 0; j < 2; ++j) {
      const int m = wm * 64 + j * 32 + r;
#pragma unroll
      for (int i = 0; i < 2; ++i)
#pragma unroll
        for (int q = 0; q < 4; ++q) {
          const int n = nt * 128 + wn * 64 + i * 32 + 8 * q + 4 * h;
          u32x2 o; o[0] = pk2(macc[i][j][4 * q], macc[i][j][4 * q + 1]); o[1] = pk2(macc[i][j][4 * q + 2], macc[i][j][4 * q + 3]);
          *(u32x2*)(out + (size_t)m * DM + n) = o;
        }
    }
  }
}

DI void phase_gemm3(const Params& p, int l, int g, char* smem) {
  const int tid = opq((int)threadIdx.x), lane = tid & 63, w = tid >> 6, r = lane & 31, h = lane >> 5, wm = w & 3, wn = w >> 2;
  const int ntile = 256 + (g == 0 ? 8 : 0);
  for (int t = blockIdx.x; t < ntile; t += gridDim.x) {
    const bf16_t* A; const float* hin; float* hout; bf16_t* hb; float* ss; int nt;
    if (t < 256) {
      const int mt = t & 31; nt = t >> 5; const size_t row0 = (size_t)g * RG + mt * 256;
      A = P_mgd + (size_t)mt * 256 * DM; hin = (l == 0 ? p.x : p.out) + row0 * DM; hout = p.out + row0 * DM; hb = P_hb + row0 * DM; ss = P_ss + (l + 1) * NROWS + row0;
    } else { nt = t - 256; A = P_mgdm; hin = P_hmeta; hout = P_hmeta; hb = P_hb + (size_t)MROW0 * DM; ss = P_ss + (l + 1) * NROWS + MROW0; }
    f32x16 acc[2][2];
#pragma unroll
    for (int i = 0; i < 2; ++i) for (int j = 0; j < 2; ++j) acc[i][j] = zero16();
    f32x4 hpre[2][2][4];
#pragma unroll
    for (int j = 0; j < 2; ++j)
#pragma unroll
      for (int i = 0; i < 2; ++i)
#pragma unroll
        for (int q = 0; q < 4; ++q)
          hpre[j][i][q] = *(const f32x4*)(hin + (size_t)(wm * 64 + j * 32 + r) * DM + nt * 128 + wn * 64 + i * 32 + 8 * q + 4 * h);
    gemm_main(A, DM, P_WoutT + ((size_t)l * DM + nt * 128) * DM, DM, DM, smem, acc, t >= 256);
#pragma unroll
    for (int j = 0; j < 2; ++j) {
      const int m = wm * 64 + j * 32 + r;
      float sq = 0.f;
#pragma unroll
      for (int i = 0; i < 2; ++i)
#pragma unroll
        for (int q = 0; q < 4; ++q) {
          const int n = nt * 128 + wn * 64 + i * 32 + 8 * q + 4 * h;
          f32x4 hv = hpre[j][i][q];
#pragma unroll
          for (int e = 0; e < 4; ++e) { hv[e] += acc[i][j][4 * q + e]; sq += hv[e] * hv[e]; }
          *(f32x4*)(hout + (size_t)m * DM + n) = hv;
          if (l == 0) { u32x2 o; o[0] = pk2(hv[0], hv[1]); o[1] = pk2(hv[2], hv[3]); *(u32x2*)(hb + (size_t)m * DM + n) = o; }
        }
      sq += __shfl_xor(sq, 32);
      if (h == 0) atomicAdd(ss + m, sq);
    }
  }
}

DI void phase_final(const Params& p) {
  const int tid = opq((int)threadIdx.x), lane = tid & 63, gw = blockIdx.x * 8 + (tid >> 6), ngw = gridDim.x * 8;
  for (int row = gw; row < MROW0; row += ngw) {
    const float rs = rsqrtf(P_ss[2 * NROWS + row] * (1.f / DM) + EPS);
    float* o = p.out + (size_t)row * DM;
#pragma unroll
    for (int q = 0; q < 4; ++q) {
      f32x4 v = *(const f32x4*)(o + q * 256 + lane * 4);
      const f32x4 fn = *(const f32x4*)(p.fnorm + q * 256 + lane * 4);
      v = v * rs * fn;
      *(f32x4*)(o + q * 256 + lane * 4) = v;
    }
  }
}

__global__ void __launch_bounds__(NTHR) hybrid_mega(Params p) {
  extern __shared__ __attribute__((aligned(16))) char smem[];
  cg::grid_group grid = cg::this_grid();
  unsigned epoch = xb_xcc_id();
  if (threadIdx.x == 0) {
    volatile __attribute__((address_space(3))) unsigned* st = (volatile __attribute__((address_space(3))) unsigned*)(unsigned)(LDS_BYTES - 32);
    st[0] = 0u; st[1] = 0u;
    (void)xb_add(&(P_ctrl + 1024)[XB_XCNT(epoch)], 1u);
  }
  __syncthreads();
  prologue(p, smem);
  grid.sync();
  phase_gemm1(p, 0, 0, smem); gbar(P_ctrl, epoch);
#pragma unroll 1
  for (int l = 0; l < 2; ++l) {
#pragma unroll 1
    for (int g = 0; g < NGRP; ++g) {
      phase_local(p, l, g, smem); gbar(P_ctrl, epoch);
      phase_scan_states(p, l, g); gbar(P_ctrl, epoch);
      phase_output(p, l, g, smem); gbar(P_ctrl, epoch);
      phase_gemm2(p, l, g, smem); gbar(P_ctrl, epoch);
      phase_gemm3(p, l, g, smem);
      {
        const int gn = (g + 1) % NGRP, ln = l + (g + 1) / NGRP;
        if (ln < 2) phase_gemm1(p, ln, gn, smem);
      }
      gbar(P_ctrl, epoch);
    }
  }
  phase_final(p);
}

extern "C" void kernel_launch(void* const* d_in, const int* in_sizes, int n_in, void* d_out, int out_size, void* d_ws, size_t ws_size, hipStream_t stream) {
  Params p;
  memset(&p, 0, sizeof(p));
  const float* const* in = (const float* const*)d_in;
  p.x = in[0]; p.meta = in[1]; p.lbl = in[2]; p.fnorm = in[3]; p.ng = in[4]; p.w_in = in[5]; p.w_br = in[6]; p.w_out = in[7];
  p.w_lr = in[8]; p.b_lr = in[9]; p.gnorm = in[10]; p.hnorm = in[11]; p.lam_re = in[12]; p.lam_im = in[13]; p.log_dt = in[14];
  p.b_re = in[15]; p.b_im = in[16]; p.c_re = in[17]; p.c_im = in[18]; p.s5d = in[19]; p.gluw = in[20]; p.glub = in[21];
  p.convw = in[22]; p.convb = in[23]; p.wa = in[24]; p.ba = in[25]; p.wx = in[26]; p.bx = in[27]; p.lam = in[28];
  p.out = (float*)d_out;
  p.ws = (char*)d_ws; const size_t off = WS_NEED;
  static int grid_blocks = 0;
  if (!grid_blocks) {
    if (off > ws_size) { fprintf(stderr, "kernel_launch: workspace too small: need %zu have %zu\n", off, ws_size); grid_blocks = -1; }
    else {
      int dev = 0, cus = 0, per_cu = 0;
      hipGetDevice(&dev);
      hipDeviceGetAttribute(&cus, hipDeviceAttributeMultiprocessorCount, dev);
      hipFuncSetAttribute((const void*)hybrid_mega, hipFuncAttributeMaxDynamicSharedMemorySize, LDS_BYTES);
      hipOccupancyMaxActiveBlocksPerMultiprocessor(&per_cu, hybrid_mega, NTHR, LDS_BYTES);
      if (per_cu < 1) { fprintf(stderr, "kernel_launch: occupancy query returned %d\n", per_cu); grid_blocks = -1; }
      else grid_blocks = cus;
    }
  }
  if (grid_blocks <= 0) return;
  hipMemsetAsync(p.ws + O_ctrl, 0, 20480, stream);
  void* args[] = {&p};
  hipError_t e = hipLaunchCooperativeKernel((void*)hybrid_mega, dim3(grid_blocks), dim3(NTHR), args, LDS_BYTES, stream);
  if (e != hipSuccess) fprintf(stderr, "cooperative launch failed: %s (grid %d)\n", hipGetErrorString(e), grid_blocks);
}
```

```cpp
#include <hip/hip_runtime.h>
#include <hip/hip_cooperative_groups.h>
#include <cstdio>
#include <cstdint>
#include <cstring>
namespace cg = cooperative_groups;

typedef unsigned short bf16_t;
typedef short bf16x8 __attribute__((ext_vector_type(8)));
typedef short bf16x4 __attribute__((ext_vector_type(4)));
typedef float f32x16 __attribute__((ext_vector_type(16)));
typedef float f32x4 __attribute__((ext_vector_type(4)));
typedef unsigned u32x4 __attribute__((ext_vector_type(4)));
typedef unsigned u32x2 __attribute__((ext_vector_type(2)));

#define DI __device__ __forceinline__
#define MFMA32(a, b, c) __builtin_amdgcn_mfma_f32_32x32x16_bf16((a), (b), (c), 0, 0, 0)

constexpr int DM = 1024, NBAT = 8, SEQ = 4096, NMETA = 16;
constexpr int NB = 2;
constexpr int NGRP = NBAT / NB;
constexpr int RG = NB * SEQ;
constexpr int NCH = SEQ / 32;
constexpr int NUNIT = NB * NCH;
constexpr int ZW = 9856;
constexpr int INW = 9744;
constexpr int ZC_GQ = 0, ZC_GK = 256, ZC_GV = 512, ZC_GG = 1024, ZC_HQ = 1536, ZC_HF = 2048, ZC_HI = 2560, ZC_HG = 3072,
              ZC_SU = 3584, ZC_SG = 4096, ZC_LX = 4608, ZC_LG = 5120, ZC_LR = 5632, ZC_MG = 5760;
constexpr int MROW0 = NBAT * SEQ;
constexpr int NROWS = MROW0 + 256;
constexpr float EPS = 1e-6f;
constexpr int LDS_BYTES = 147968;
constexpr int NTHR = 512;
#ifndef SCAN_U
#define SCAN_U 32
#endif

struct Params {
  const float *x, *meta, *lbl, *fnorm, *ng, *w_in, *w_br, *w_out, *w_lr, *b_lr, *gnorm, *hnorm;
  const float *lam_re, *lam_im, *log_dt, *b_re, *b_im, *c_re, *c_im, *s5d, *gluw, *glub;
  const float *convw, *convb, *wa, *ba, *wx, *bx, *lam;
  float* out;
  char* ws;
};
constexpr size_t al256(size_t x) { return (x + 255) & ~(size_t)255; }
constexpr size_t O_ctrl = 0;
constexpr size_t O_ss = O_ctrl + al256(20480);
constexpr size_t O_hmeta = O_ss + al256((size_t)3*NROWS*4);
constexpr size_t O_hb = O_hmeta + al256((size_t)256*DM*4);
constexpr size_t O_WinT = O_hb + al256((size_t)NROWS*DM*2);
constexpr size_t O_WbT = O_WinT + al256((size_t)2*ZW*DM*2);
constexpr size_t O_WoutT = O_WbT + al256((size_t)8*DM*512*2);
constexpr size_t O_gluT = O_WoutT + al256((size_t)2*DM*DM*2);
constexpr size_t O_waT = O_gluT + al256((size_t)2*512*512*2);
constexpr size_t O_wxT = O_waT + al256((size_t)16*4096*2);
constexpr size_t O_TM = O_wxT + al256((size_t)16*4096*2);
constexpr size_t O_PS = O_TM + al256((size_t)64*512*640*2);
constexpr size_t O_AL = O_PS + al256((size_t)64*128*512*2);
constexpr size_t O_zg = O_AL + al256((size_t)64*64*2*4);
constexpr size_t O_zm = O_zg + al256((size_t)RG*ZW*2);
constexpr size_t O_ysg = O_zm + al256((size_t)256*ZW*2);
constexpr size_t O_ysm = O_ysg + al256((size_t)RG*2048*2);
constexpr size_t O_mgd = O_ysm + al256((size_t)256*2048*2);
constexpr size_t O_mgdm = O_mgd + al256((size_t)RG*DM*2);
constexpr size_t O_ygg = O_mgdm + al256((size_t)256*DM*2);
constexpr size_t O_ygm = O_ygg + al256((size_t)RG*512*2);
constexpr size_t O_kvA = O_ygm + al256((size_t)256*512*2);
constexpr size_t O_kvB = O_kvA + al256((size_t)NUNIT*32768*4);
constexpr size_t O_kvAm = O_kvB + al256((size_t)NUNIT*65536*4);
constexpr size_t O_kvBm = O_kvAm + al256((size_t)32768*4);
constexpr size_t O_decA = O_kvBm + al256((size_t)65536*4);
constexpr size_t O_decB = O_decA + al256((size_t)NUNIT*256*4);
constexpr size_t O_hloc = O_decB + al256((size_t)NUNIT*512*4);
constexpr size_t O_cumA = O_hloc + al256((size_t)RG*512*2);
constexpr size_t O_hlocm = O_cumA + al256((size_t)RG*512*2);
constexpr size_t O_cumAm = O_hlocm + al256((size_t)32*512*2);
constexpr size_t O_cha = O_cumAm + al256((size_t)32*512*2);
constexpr size_t O_chh = O_cha + al256((size_t)NUNIT*512*4);
constexpr size_t O_cin = O_chh + al256((size_t)NUNIT*512*4);
constexpr size_t O_chhm = O_cin + al256((size_t)NUNIT*512*4);
constexpr size_t O_qkA = O_chhm + al256((size_t)512*4);
constexpr size_t O_qkm = O_qkA + al256((size_t)NUNIT*16384*2);
constexpr size_t WS_NEED = O_qkm + al256((size_t)3*16384*2);
static_assert(WS_NEED <= (size_t)536870912, "workspace budget");
#define P_ctrl ((unsigned*)(p.ws + O_ctrl))
#define P_ss ((float*)(p.ws + O_ss))
#define P_hmeta ((float*)(p.ws + O_hmeta))
#define P_hb ((bf16_t*)(p.ws + O_hb))
#define P_WinT ((bf16_t*)(p.ws + O_WinT))
#define P_WbT ((bf16_t*)(p.ws + O_WbT))
#define P_WoutT ((bf16_t*)(p.ws + O_WoutT))
#define P_gluT ((bf16_t*)(p.ws + O_gluT))
#define P_waT ((bf16_t*)(p.ws + O_waT))
#define P_wxT ((bf16_t*)(p.ws + O_wxT))
#define P_TM ((bf16_t*)(p.ws + O_TM))
#define P_PS ((bf16_t*)(p.ws + O_PS))
#define P_AL ((float*)(p.ws + O_AL))
#define P_zg ((bf16_t*)(p.ws + O_zg))
#define P_zm ((bf16_t*)(p.ws + O_zm))
#define P_ysg ((bf16_t*)(p.ws + O_ysg))
#define P_ysm ((bf16_t*)(p.ws + O_ysm))
#define P_mgd ((bf16_t*)(p.ws + O_mgd))
#define P_mgdm ((bf16_t*)(p.ws + O_mgdm))
#define P_ygg ((bf16_t*)(p.ws + O_ygg))
#define P_ygm ((bf16_t*)(p.ws + O_ygm))
#define P_kvA ((float*)(p.ws + O_kvA))
#define P_kvB ((float*)(p.ws + O_kvB))
#define P_kvAm ((float*)(p.ws + O_kvAm))
#define P_kvBm ((float*)(p.ws + O_kvBm))
#define P_decA ((float*)(p.ws + O_decA))
#define P_decB ((float*)(p.ws + O_decB))
#define P_hloc ((bf16_t*)(p.ws + O_hloc))
#define P_cumA ((bf16_t*)(p.ws + O_cumA))
#define P_hlocm ((bf16_t*)(p.ws + O_hlocm))
#define P_cumAm ((bf16_t*)(p.ws + O_cumAm))
#define P_cha ((float*)(p.ws + O_cha))
#define P_chh ((float*)(p.ws + O_chh))
#define P_cin ((float*)(p.ws + O_cin))
#define P_chhm ((float*)(p.ws + O_chhm))
#define P_qkA ((bf16_t*)(p.ws + O_qkA))
#define P_qkm ((bf16_t*)(p.ws + O_qkm))


typedef __bf16 bf16v2_t __attribute__((ext_vector_type(2)));
typedef float f32v2_t __attribute__((ext_vector_type(2)));
DI bf16_t f2bf(float x) { const __bf16 b = (__bf16)x; return __builtin_bit_cast(unsigned short, b); }
DI float bf2f(bf16_t b) { return __uint_as_float(((unsigned)b) << 16); }
DI unsigned pk2(float lo, float hi) { const f32v2_t v = {lo, hi}; const bf16v2_t b = __builtin_convertvector(v, bf16v2_t); return __builtin_bit_cast(unsigned, b); }
DI float sigmoidf_(float x) { return __builtin_amdgcn_rcpf(1.f + __expf(-x)); }
DI float siluf_(float x) { return x * __builtin_amdgcn_rcpf(1.f + __expf(-x)); }
DI float logsigmoidf_(float x) { return fminf(x, 0.f) - __logf(1.f + __expf(-fabsf(x))); }
DI float softplusf_(float x) { return fmaxf(x, 0.f) + __logf(1.f + __expf(-fabsf(x))); }
DI float geluf_(float x) { const float u = 0.7978845608028654f * (x + 0.044715f * x * x * x); return x * __builtin_amdgcn_rcpf(1.f + __expf(-2.f * u)); }
DI int opq(int x) { asm volatile("" : "+v"(x)); return x; }
DI int opqs(int x) { asm volatile("" : "+s"(x)); return x; }
DI int crow(int reg, int h) { return (reg & 3) + 8 * (reg >> 2) + 4 * h; }
DI f32x16 zero16() { f32x16 z; for (int i = 0; i < 16; ++i) z[i] = 0.f; return z; }
DI bf16x8 pack8(float a0, float a1, float a2, float a3, float a4, float a5, float a6, float a7) {
  u32x4 p; p[0] = pk2(a0, a1); p[1] = pk2(a2, a3); p[2] = pk2(a4, a5); p[3] = pk2(a6, a7);
  return __builtin_bit_cast(bf16x8, p);
}

#define XB_TMO      128
#define XB_XCNT(j)  (256  + 64 * (j))
#define XB_XSUB(j)  (1280 + 64 * (j))
#define XB_XGEN(j)  (2304 + 64 * (j))
#define XB_TOP      3328
#define XB_TOPGEN   3392
#define XB_SPIN_CAP (1u << 22)
DI unsigned xb_ld(unsigned* p) { return __hip_atomic_load(p, __ATOMIC_RELAXED, __HIP_MEMORY_SCOPE_AGENT); }
DI unsigned xb_add(unsigned* p, unsigned v) { return __hip_atomic_fetch_add(p, v, __ATOMIC_RELAXED, __HIP_MEMORY_SCOPE_AGENT); }
DI unsigned xb_xcc_id() { return (unsigned)__builtin_amdgcn_s_getreg((3 << 11) | 20) & 0xFu; }
#define XB_SPIN(cond, bar) do { unsigned _sp = 0; while (cond) { __builtin_amdgcn_s_sleep(1); \
    if ((++_sp & 255u) == 0u) { if (xb_ld(&(bar)[XB_TMO])) break; if (_sp > XB_SPIN_CAP) { atomicAdd(&(bar)[XB_TMO], 1u); break; } } } } while (0)
DI void xcd_barrier_complete(unsigned* bar, unsigned x, unsigned& nloc, unsigned& nx) {
  const unsigned G = gridDim.x;
  unsigned sum, cnt, mine, sp = 0u;
  for (;;) {
    sum = 0u; cnt = 0u; mine = 0u;
#pragma unroll
    for (unsigned j = 0; j < 16; ++j) { const unsigned c = xb_ld(&bar[XB_XCNT(j)]); sum += c; cnt += (c > 0u) ? 1u : 0u; mine = (j == x) ? c : mine; }
    if (sum == G) break;
    __builtin_amdgcn_s_sleep(1);
    if ((++sp & 255u) == 0u) { if (xb_ld(&bar[XB_TMO])) break; if (sp > XB_SPIN_CAP) { atomicAdd(&bar[XB_TMO], 1u); break; } }
  }
  nloc = mine > 0u ? mine : 1u; nx = cnt > 0u ? cnt : 1u;
}
DI void gbar(unsigned* ctrl, unsigned& xcc) {
  unsigned* bar = ctrl + 1024;
  volatile __attribute__((address_space(3))) unsigned* st = (volatile __attribute__((address_space(3))) unsigned*)(unsigned)(LDS_BYTES - 32);
  asm volatile("s_waitcnt vmcnt(0)" ::: "memory");
  __syncthreads();
  if (threadIdx.x == 0) {
    __builtin_amdgcn_s_waitcnt(0);
    unsigned nloc = st[0], nx = st[1];
    if (nloc == 0u) { xcd_barrier_complete(bar, xcc, nloc, nx); st[0] = nloc; st[1] = nx; }
    const unsigned old = xb_add(&bar[XB_XSUB(xcc)], 1u);
    const unsigned gen = old / nloc;
    if (old + 1u == (gen + 1u) * nloc) {
      __builtin_amdgcn_fence(__ATOMIC_RELEASE, "agent");
      asm volatile("s_waitcnt vmcnt(0)" ::: "memory");
      const unsigned og = xb_add(&bar[XB_TOP], 1u);
      const unsigned tg = og / nx;
      if (og + 1u == (tg + 1u) * nx) xb_add(&bar[XB_TOPGEN], 1u);
      else XB_SPIN(xb_ld(&bar[XB_TOPGEN]) == tg, bar);
      __builtin_amdgcn_fence(__ATOMIC_ACQUIRE, "agent");
      xb_add(&bar[XB_XGEN(xcc)], 1u);
      asm volatile("s_waitcnt vmcnt(0)" ::: "memory");
    } else {
      XB_SPIN(xb_ld(&bar[XB_XGEN(xcc)]) == gen, bar);
      __builtin_amdgcn_fence(__ATOMIC_ACQUIRE, "agent");
      asm volatile("s_waitcnt vmcnt(0)" ::: "memory");
    }
  }
  __syncthreads();
}

DI int swz(int r, int c) { return r * 128 + ((c ^ ((r >> 1) & 7)) << 4); }

DI void gemm_main(const bf16_t* __restrict__ A, int lda, const bf16_t* __restrict__ Bt, int ldb, int K, char* lds, f32x16 (&acc)[2][2], int small = 0,
                  const bf16_t* __restrict__ gate = nullptr, int gate_ld = 0) {
  const int tid = opq((int)threadIdx.x), lane = tid & 63, w = tid >> 6, r = lane & 31, h = lane >> 5;
  const int wm = w & 3, wn = w >> 2;
  const int lrow = tid >> 3, lc = (tid & 7) ^ ((tid >> 4) & 7);
  const bf16_t* ga = A + (size_t)lrow * lda + lc * 8;
  const bf16_t* gb = Bt + (size_t)lrow * ldb + lc * 8;
  const int nk = K >> 6;
  typedef __attribute__((address_space(3))) unsigned lds_u32;
#define G_STAGE(S, KT) do { char* sb_ = lds + (S) * 49152 + tid * 16; \
    _Pragma("unroll") for (int u = 0; u < 4; ++u) __builtin_amdgcn_global_load_lds((const unsigned*)(ga + (size_t)(64 * u) * lda + (KT) * 64), (lds_u32*)(sb_ + u * 8192), 16, 0, 0); \
    _Pragma("unroll") for (int u = 0; u < 2; ++u) __builtin_amdgcn_global_load_lds((const unsigned*)(gb + (size_t)(64 * u) * ldb + (KT) * 64), (lds_u32*)(sb_ + 32768 + u * 8192), 16, 0, 0); } while (0)
#define G_COMPUTE(S) do { const char* la_ = lds + (S) * 49152; const char* lb_ = la_ + 32768; \
    if (!small) { \
    _Pragma("unroll") for (int ks = 0; ks < 4; ++ks) { \
      bf16x8 xf[2], wf[2]; \
      _Pragma("unroll") for (int j = 0; j < 2; ++j) xf[j] = *(const bf16x8*)(la_ + swz(wm * 64 + j * 32 + r, ks * 2 + h)); \
      _Pragma("unroll") for (int i = 0; i < 2; ++i) wf[i] = *(const bf16x8*)(lb_ + swz(wn * 64 + i * 32 + r, ks * 2 + h)); \
      _Pragma("unroll") for (int i = 0; i < 2; ++i) _Pragma("unroll") for (int j = 0; j < 2; ++j) acc[i][j] = MFMA32(wf[i], xf[j], acc[i][j]); } \
    } else if (wm == 0) { \
    _Pragma("unroll") for (int ks = 0; ks < 4; ++ks) { \
      const bf16x8 xf0 = *(const bf16x8*)(la_ + swz(r, ks * 2 + h)); \
      _Pragma("unroll") for (int i = 0; i < 2; ++i) { const bf16x8 wfi = *(const bf16x8*)(lb_ + swz(wn * 64 + i * 32 + r, ks * 2 + h)); acc[i][0] = MFMA32(wfi, xf0, acc[i][0]); } } \
    } } while (0)
  asm volatile("s_waitcnt vmcnt(0) lgkmcnt(0)" ::: "memory");
  __builtin_amdgcn_s_barrier();
  G_STAGE(0, 0);
  G_STAGE(1, 1);
  int s0 = 0, s1 = 1, s2 = 2;
#pragma unroll 1
  for (int kt = 0; kt < nk; ++kt) {
    if (kt + 1 < nk) asm volatile("s_waitcnt vmcnt(6)" ::: "memory");
    else asm volatile("s_waitcnt vmcnt(0)" ::: "memory");
    __builtin_amdgcn_s_barrier();
    if (kt + 2 < nk) G_STAGE(s2, kt + 2);
    else if (gate) {
      const bf16_t* gsrc = gate + (size_t)(tid >> 4) * gate_ld + (((tid & 15) ^ ((tid >> 4) & 15)) << 3);
      char* gdst = lds + s2 * 49152 + tid * 16;
      if (kt + 2 == nk) {
#pragma unroll
        for (int u = 0; u < 6; ++u) __builtin_amdgcn_global_load_lds((const unsigned*)(gsrc + (size_t)(u * 32) * gate_ld), (lds_u32*)(gdst + u * 8192), 16, 0, 0);
      } else {
#pragma unroll
        for (int u = 0; u < 2; ++u) __builtin_amdgcn_global_load_lds((const unsigned*)(gsrc + (size_t)(192 + u * 32) * gate_ld), (lds_u32*)(gdst + u * 8192), 16, 0, 0);
      }
    }
    G_COMPUTE(s0);
    const int t = s0; s0 = s1; s1 = s2; s2 = t;
  }
  asm volatile("s_waitcnt vmcnt(0) lgkmcnt(0)" ::: "memory");
  __builtin_amdgcn_s_barrier();
#undef G_STAGE
#undef G_COMPUTE
}

DI int swz32(int r, int c) { return r * 64 + ((c ^ ((r >> 2) & 3)) << 4); }
DI void gemm_main_256(const bf16_t* __restrict__ A, int lda, const bf16_t* __restrict__ Bt, int ldb, int K, char* lds, f32x16 (&acc)[2][4]) {
  const int tid = opq((int)threadIdx.x), lane = tid & 63, w = tid >> 6, r = lane & 31, h = lane >> 5;
  const int wm = w & 1, wn = w >> 1;
  const int lrow = tid >> 2, lc = (tid & 3) ^ ((tid >> 4) & 3);
  const bf16_t* ga = A + (size_t)lrow * lda + lc * 8;
  const bf16_t* gb = Bt + (size_t)lrow * ldb + lc * 8;
  const int nk = K >> 5;
  typedef __attribute__((address_space(3))) unsigned lds_u32;
#define H_STAGE(S, KT) do { char* sb_ = lds + (S) * 32768 + tid * 16; \
    _Pragma("unroll") for (int u = 0; u < 2; ++u) __builtin_amdgcn_global_load_lds((const unsigned*)(ga + (size_t)(128 * u) * lda + (KT) * 32), (lds_u32*)(sb_ + u * 8192), 16, 0, 0); \
    _Pragma("unroll") for (int u = 0; u < 2; ++u) __builtin_amdgcn_global_load_lds((const unsigned*)(gb + (size_t)(128 * u) * ldb + (KT) * 32), (lds_u32*)(sb_ + 16384 + u * 8192), 16, 0, 0); } while (0)
#define H_COMPUTE(S) do { const char* la_ = lds + (S) * 32768; const char* lb_ = la_ + 16384; \
    _Pragma("unroll") for (int ks = 0; ks < 2; ++ks) { \
      bf16x8 xf[4], wf[2]; \
      _Pragma("unroll") for (int i = 0; i < 2; ++i) wf[i] = *(const bf16x8*)(lb_ + swz32(wn * 64 + i * 32 + r, ks * 2 + h)); \
      _Pragma("unroll") for (int j = 0; j < 4; ++j) xf[j] = *(const bf16x8*)(la_ + swz32(wm * 128 + j * 32 + r, ks * 2 + h)); \
      _Pragma("unroll") for (int j = 0; j < 4; ++j) _Pragma("unroll") for (int i = 0; i < 2; ++i) acc[i][j] = MFMA32(wf[i], xf[j], acc[i][j]); } } while (0)
  asm volatile("s_waitcnt vmcnt(0) lgkmcnt(0)" ::: "memory");
  __builtin_amdgcn_s_barrier();
  H_STAGE(0, 0);
  H_STAGE(1, 1);
  H_STAGE(2, 2);
#pragma unroll 1
  for (int kt = 0; kt < nk; ++kt) {
    const int rem = nk - 1 - kt;
    if (rem >= 2) asm volatile("s_waitcnt vmcnt(8)" ::: "memory");
    else if (rem == 1) asm volatile("s_waitcnt vmcnt(4)" ::: "memory");
    else asm volatile("s_waitcnt vmcnt(0)" ::: "memory");
    __builtin_amdgcn_s_barrier();
    if (kt + 3 < nk) H_STAGE((kt + 3) & 3, kt + 3);
    H_COMPUTE(kt & 3);
  }
  asm volatile("s_waitcnt lgkmcnt(0)" ::: "memory");
  __builtin_amdgcn_s_barrier();
#undef H_STAGE
#undef H_COMPUTE
}

DI int win_origcol(int n) { return n < 1024 ? n : (n < 5632 ? n + 16 : (n < 5648 ? n - 5632 + 1024 : (n < 5760 ? -1 : n - 112))); }

DI void transpose_tile(const float* __restrict__ src, int src_ld, int k0, int n0, bool winmap, const float* __restrict__ scale,
                       bf16_t* __restrict__ dst, int dst_ld, float* t) {
  const int tid = opq((int)threadIdx.x);
  const int nn = tid & 63, kb = tid >> 6;
  int col = n0 + nn; if (winmap) col = win_origcol(col);
#pragma unroll
  for (int it = 0; it < 8; ++it) {
    const int kk = kb + 8 * it;
    float v = 0.f;
    if (col >= 0) { v = __builtin_nontemporal_load(src + (size_t)(k0 + kk) * src_ld + col); if (scale) v *= scale[k0 + kk]; }
    t[kk * 65 + nn] = v;
  }
  __syncthreads();
  const int n2 = tid >> 3, kc = tid & 7;
  u32x4 o;
#pragma unroll
  for (int e = 0; e < 4; ++e) o[e] = pk2(t[(kc * 8 + 2 * e) * 65 + n2], t[(kc * 8 + 2 * e + 1) * 65 + n2]);
  *(u32x4*)(dst + (size_t)(n0 + n2) * dst_ld + k0 + kc * 8) = o;
  __syncthreads();
}

DI void s5_precompute(const Params& p, int l, int g, char* smem) {
  float* Apr = (float*)smem;
  float* Api = Apr + 33 * 64;
  float* Cre = Api + 33 * 64;
  float* Cim = Cre + 1024;
  float* Bre = Cim + 1024;
  float* Bim = Bre + 1024;
  float* Kt = Bim + 1024;
  const int tid = opq((int)threadIdx.x);
  const int lg = l * 32 + g;
  if (tid < 64) {
    const int n = tid;
    const float lr = p.lam_re[lg * 64 + n], li = p.lam_im[lg * 64 + n], dt = expf(p.log_dt[lg]);
    const float mag = expf(lr * dt), are = mag * cosf(li * dt), aim = mag * sinf(li * dt);
    const float nr = are - 1.f, ni = aim, den = lr * lr + li * li;
    const float cr = (nr * lr + ni * li) / den, ci = (ni * lr - nr * li) / den;
    for (int c = 0; c < 16; ++c) {
      const float br = p.b_re[(lg * 64 + n) * 16 + c], bi = p.b_im[(lg * 64 + n) * 16 + c];
      Bre[n * 16 + c] = cr * br - ci * bi; Bim[n * 16 + c] = cr * bi + ci * br;
    }
  }
  for (int idx = tid; idx < 33 * 64; idx += NTHR) {
    const int m = idx >> 6, n = idx & 63;
    const float lr = p.lam_re[lg * 64 + n], li = p.lam_im[lg * 64 + n], dt = expf(p.log_dt[lg]);
    const float mg = expf(lr * dt * (float)m), ang = li * dt * (float)m;
    Apr[idx] = mg * cosf(ang); Api[idx] = mg * sinf(ang);
    if (m == 32) { P_AL[(lg * 64 + n) * 2 + 0] = Apr[idx]; P_AL[(lg * 64 + n) * 2 + 1] = Api[idx]; }
  }
  for (int idx = tid; idx < 1024; idx += NTHR) { Cre[idx] = p.c_re[lg * 1024 + idx]; Cim[idx] = p.c_im[lg * 1024 + idx]; }
  __syncthreads();
  for (int e = tid; e < 8192; e += NTHR) {
    const int m = e >> 8, c = (e >> 4) & 15, c2 = e & 15;
    float s = 0.f;
    for (int n = 0; n < 64; ++n) {
      const float ar = Apr[m * 64 + n], ai = Api[m * 64 + n], br = Bre[n * 16 + c2], bi = Bim[n * 16 + c2];
      const float wr = ar * br - ai * bi, wi = ar * bi + ai * br;
      s += Cre[c * 64 + n] * wr - Cim[c * 64 + n] * wi;
    }
    Kt[e] = s;
  }
  __syncthreads();
  bf16_t* TMg = P_TM + (size_t)lg * 512 * 640;
  {
    const int s = tid >> 4, c2 = tid & 15;
    for (int row = 0; row < 512; ++row) {
      const int j = row >> 4, c = row & 15;
      const float v = (s <= j) ? Kt[((j - s) << 8) + (c << 4) + c2] : 0.f;
      TMg[row * 640 + tid] = f2bf(v);
    }
  }
  for (int idx = tid; idx < 512 * 128; idx += NTHR) {
    const int row = idx >> 7, kk = idx & 127, j = row >> 4, c = row & 15, n = kk & 63, im = kk >> 6;
    const float ar = Apr[(j + 1) * 64 + n], ai = Api[(j + 1) * 64 + n], cr = Cre[c * 64 + n], ci = Cim[c * 64 + n];
    TMg[row * 640 + 512 + kk] = f2bf(im ? -(cr * ai + ci * ar) : (cr * ar - ci * ai));
  }
  bf16_t* Pg = P_PS + (size_t)lg * 128 * 512;
  for (int e = tid; e < 128 * 512; e += NTHR) {
    const int row = e >> 9, k = e & 511, n = row & 63, s = k >> 4, c2 = k & 15, m = 31 - s;
    const float ar = Apr[m * 64 + n], ai = Api[m * 64 + n], br = Bre[n * 16 + c2], bi = Bim[n * 16 + c2];
    Pg[e] = f2bf(row < 64 ? (ar * br - ai * bi) : (ar * bi + ai * br));
  }
  __syncthreads();
}

DI void prologue(const Params& p, char* smem) {
  const int tid = opq((int)threadIdx.x), bid = blockIdx.x, nb = gridDim.x;
  constexpr int T_WIN = 16 * 154;
  constexpr int T_WB = 8 * 16;
  constexpr int T_WO = 16 * 16;
  constexpr int T_GL = 8 * 8;
  constexpr int NT_ALL = 2 * T_WIN + 8 * T_WB + 2 * T_WO + 2 * T_GL + 32;
  float* tbuf = (float*)smem;
  constexpr int NT_HEAD = 192 * 20;
  const bool s5wg = (bid < 64) && (nb > 64);
  if (s5wg) s5_precompute(p, bid >> 5, bid & 31, smem);
  for (int it = (s5wg ? NT_HEAD + bid : (nb > 64 ? bid - 64 : bid)); it < NT_ALL; ) {
    int t = it;
    if (nb > 64) it += (it < NT_HEAD) ? (nb - 64) : nb; else it += nb;
    if (nb > 64 && t < NT_HEAD && it >= NT_HEAD) it = NT_HEAD + bid;
    if (t < 2 * T_WIN) {
      const int l = t / T_WIN, tt = t % T_WIN, kt = tt / 154, nt = tt % 154;
      transpose_tile(p.w_in + (size_t)l * DM * INW, INW, kt * 64, nt * 64, true, p.ng + l * DM, P_WinT + (size_t)l * ZW * DM, DM, tbuf);
      continue;
    }
    t -= 2 * T_WIN;
    if (t < 8 * T_WB) {
      const int lb = t / T_WB, tt = t % T_WB, kt = tt / 16, nt = tt % 16;
      transpose_tile(p.w_br + (size_t)lb * 512 * DM, DM, kt * 64, nt * 64, false, nullptr, P_WbT + (size_t)lb * DM * 512, 512, tbuf);
      continue;
    }
    t -= 8 * T_WB;
    if (t < 2 * T_WO) {
      const int l = t / T_WO, tt = t % T_WO, kt = tt / 16, nt = tt % 16;
      transpose_tile(p.w_out + (size_t)l * DM * DM, DM, kt * 64, nt * 64, false, nullptr, P_WoutT + (size_t)l * DM * DM, DM, tbuf);
      continue;
    }
    t -= 2 * T_WO;
    if (t < 2 * T_GL) {
      const int l = t / T_GL, tt = t % T_GL, kt = tt / 8, nt = tt % 8;
      transpose_tile(p.gluw + (size_t)l * 512 * 512, 512, kt * 64, nt * 64, false, nullptr, P_gluT + (size_t)l * 512 * 512, 512, tbuf);
      continue;
    }
    t -= 2 * T_GL;
    {
      const int which = t >> 4, lk = t & 15;
      transpose_tile((which ? p.wx : p.wa) + (size_t)lk * 4096, 64, 0, 0, false, nullptr, (which ? P_wxT : P_waT) + (size_t)lk * 4096, 64, tbuf);
    }
  }
  {
    const int lane = tid & 63, gw = bid * 8 + (tid >> 6), ngw = nb * 8;
    for (int row = gw; row < NROWS; row += ngw) {
      const float* src = nullptr;
      if (row < MROW0) src = p.x + (size_t)row * DM;
      else { const int j = row - MROW0; if (j >= 16 && j < 32) src = p.meta + (size_t)(j - 16) * DM; }
      float s = 0.f;
#pragma unroll
      for (int q = 0; q < 4; ++q) {
        f32x4 v = {0.f, 0.f, 0.f, 0.f};
        if (src) v = __builtin_nontemporal_load((const f32x4*)(src + q * 256 + lane * 4));
        s += v[0] * v[0] + v[1] * v[1] + v[2] * v[2] + v[3] * v[3];
        u32x2 o; o[0] = pk2(v[0], v[1]); o[1] = pk2(v[2], v[3]);
        *(u32x2*)(P_hb + (size_t)row * DM + q * 256 + lane * 4) = o;
        if (row >= MROW0) *(f32x4*)(P_hmeta + (size_t)(row - MROW0) * DM + q * 256 + lane * 4) = v;
      }
#pragma unroll
      for (int o = 1; o < 64; o <<= 1) s += __shfl_xor(s, o);
      if (lane == 0) { P_ss[row] = s; P_ss[NROWS + row] = 0.f; P_ss[2 * NROWS + row] = 0.f; }
    }
  }
  if (nb <= 64) for (int it = bid; it < 64; it += nb) s5_precompute(p, it >> 5, it & 31, smem);
}

struct UnitD {
  const bf16_t* z; const bf16_t* halo; bf16_t* ys;
  bf16_t *kvA, *kvB; const bf16_t *sA, *sB; float *decA, *decB;
  bf16_t *hloc, *cumA; float *cha, *chh; const float* cin;
  int pad, meta, uu;
};
DI UnitD make_unit(const Params& p, int uu) {
  UnitD u;
  if (uu < NUNIT) {
    const int bl = uu / NCH, c = uu % NCH; const size_t rb = (size_t)bl * SEQ + c * 32;
    u.z = P_zg + rb * ZW; u.halo = c > 0 ? (u.z - 3 * ZW) : (P_zm + 29 * ZW); u.ys = P_ysg + rb * 2048;
    u.kvA = (bf16_t*)P_kvA + (size_t)uu * 32768; u.kvB = (bf16_t*)P_kvB + (size_t)uu * 65536;
    u.sA = (const bf16_t*)P_kvA + (size_t)(NUNIT + uu) * 32768; u.sB = (const bf16_t*)P_kvB + (size_t)(NUNIT + uu) * 65536; u.decA = P_decA + uu * 256; u.decB = P_decB + uu * 512;
    u.hloc = P_hloc + rb * 512; u.cumA = P_cumA + rb * 512; u.cha = P_cha + uu * 512; u.chh = P_chh + uu * 512; u.cin = P_cin + uu * 512;
    u.pad = 0; u.meta = 0; u.uu = uu;
  } else {
    u.z = P_zm; u.halo = nullptr; u.ys = P_ysm; u.kvA = (bf16_t*)P_kvAm; u.kvB = (bf16_t*)P_kvBm; u.sA = nullptr; u.sB = nullptr; u.decA = nullptr; u.decB = nullptr;
    u.hloc = P_hlocm; u.cumA = P_cumAm; u.cha = nullptr; u.chh = P_chhm; u.cin = nullptr; u.pad = 16; u.meta = 1; u.uu = 0;
  }
  return u;
}

template <bool IS_GLA>
DI void gcum_build(const Params& p, const UnitD& u, int l, int half, float* Gs, float* lrs) {
  const int tid = opq((int)threadIdx.x);
  const int d = tid & 255, jh = tid >> 8;
  if (IS_GLA) {
    { const int j = tid >> 4, i = tid & 15; lrs[tid] = bf2f(u.z[(size_t)j * ZW + ZC_LR + i]); }
    __syncthreads();
    float wv[16];
#pragma unroll
    for (int i = 0; i < 16; ++i) wv[i] = p.w_lr[(l * 16 + i) * 256 + d];
    const float b = p.b_lr[l * 256 + d];
#pragma unroll 4
    for (int jj = 0; jj < 16; ++jj) {
      const int j = jh * 16 + jj;
      float a = b;
#pragma unroll
      for (int i = 0; i < 16; ++i) a += lrs[j * 16 + i] * wv[i];
      Gs[j * 256 + d] = (j < u.pad) ? 0.f : logsigmoidf_(a) * (1.f / 16.f);
    }
  } else {
    const int dg = half * 256 + d;
    const float lb = (l == 0) ? 0.f : sigmoidf_(p.lbl[512 + dg] - p.lbl[dg]);
    bf16_t raw[16];
#pragma unroll
    for (int jj = 0; jj < 16; ++jj) raw[jj] = u.z[(size_t)(jh * 16 + jj) * ZW + ZC_HF + dg];
#pragma unroll
    for (int jj = 0; jj < 16; ++jj) {
      const int j = jh * 16 + jj;
      const float f = lb + (1.f - lb) * sigmoidf_(bf2f(raw[jj]));
      Gs[j * 256 + d] = (j < u.pad) ? 0.f : __logf(f);
    }
  }
  __syncthreads();
  {
    const int dd = tid & 255, sg = tid >> 8;
    float v[16], base = 0.f;
    if (sg == 1) {
#pragma unroll
      for (int j = 0; j < 16; ++j) base += Gs[j * 256 + dd];
    }
#pragma unroll
    for (int j = 0; j < 16; ++j) v[j] = Gs[(sg * 16 + j) * 256 + dd];
    __syncthreads();
    float run = base;
#pragma unroll
    for (int j = 0; j < 16; ++j) { run += v[j]; Gs[(sg * 16 + j) * 256 + dd] = run; }
  }
  __syncthreads();
}

template <bool IS_GLA>
DI float kval_raw(bf16_t raw, float lb) {
  if (IS_GLA) return bf2f(raw);
  return 1.f - (lb + (1.f - lb) * sigmoidf_(bf2f(raw)));
}
template <bool IS_GLA>
DI float kval_of(const Params& p, const UnitD& u, int l, int half, int j, int d) {
  if (IS_GLA) return bf2f(u.z[(size_t)j * ZW + ZC_GK + d]);
  const int dg = half * 256 + d;
  const float lb = (l == 0) ? 0.f : sigmoidf_(p.lbl[512 + dg] - p.lbl[dg]);
  const float xv = bf2f(u.z[(size_t)j * ZW + ZC_HF + dg]);
  return 1.f - (lb + (1.f - lb) * sigmoidf_(xv));
}

template <bool IS_GLA>
DI bf16_t* qk_block(const Params& p, const UnitD& u, int half) {
  if (u.meta) return P_qkm + (IS_GLA ? 0 : (1 + half)) * 16384;
  if (IS_GLA) return P_qkA + (size_t)u.uu * 16384;
  return P_mgd + ((size_t)u.uu * 2 + half) * 16384;
}

template <bool IS_GLA>
DI void gla_local(const Params& p, const UnitD& u, int l, int half, char* smem) {
  constexpr int NH = IS_GLA ? 4 : 2, DK = IS_GLA ? 64 : 128, NV = NH * 128, DKT = DK / 32;
  float* Gs = (float*)smem; float* lrs = (float*)(smem + 32768);
  bf16_t* kT = (bf16_t*)(smem + 34816); bf16_t* vT = (bf16_t*)(smem + 55296);
  const int tid = opq((int)threadIdx.x), lane = tid & 63, w = tid >> 6, r = lane & 31, h = lane >> 5;
  gcum_build<IS_GLA>(p, u, l, half, Gs, lrs);
  if (!u.meta && tid < 256) {
    const float dv = __expf(Gs[31 * 256 + tid]);
    if (IS_GLA) u.decA[tid] = dv; else u.decB[half * 256 + tid] = dv;
  }
  {
    const int d = tid & 255, jb = tid >> 8;
    const int kcol = IS_GLA ? (ZC_GK + d) : (ZC_HF + half * 256 + d);
    float lb = 0.f;
    if (!IS_GLA && l != 0) lb = sigmoidf_(p.lbl[512 + half * 256 + d] - p.lbl[half * 256 + d]);
    const int qcol = IS_GLA ? (ZC_GQ + d) : (ZC_HQ + half * 256 + d);
    const float qscale = IS_GLA ? 0.125f : 1.f;
    bf16_t raw[16], rawq[16];
#pragma unroll
    for (int it = 0; it < 16; ++it) { raw[it] = u.z[(size_t)(jb * 16 + it) * ZW + kcol]; rawq[it] = u.z[(size_t)(jb * 16 + it) * ZW + qcol]; }
    const float gl = Gs[31 * 256 + d];
    bf16_t* QL = (bf16_t*)(smem + 96256); bf16_t* KL = (bf16_t*)(smem + 113152);
    float kend[16];
#pragma unroll
    for (int it = 0; it < 16; ++it) {
      const int j = jb * 16 + it;
      float kv = 0.f, qv = 0.f, kiv = 0.f;
      if (j >= u.pad) {
        const float g = Gs[j * 256 + d], kk = kval_raw<IS_GLA>(raw[it], lb);
        kv = kk * __expf(gl - g);
        qv = bf2f(rawq[it]) * qscale * __expf(g);
        kiv = kk * __expf(-g);
      }
      kend[it] = kv;
      QL[j * 264 + d] = f2bf(qv); KL[j * 264 + d] = f2bf(kiv);
    }
    u32x4 k0, k1;
#pragma unroll
    for (int e = 0; e < 4; ++e) { k0[e] = pk2(kend[2 * e], kend[2 * e + 1]); k1[e] = pk2(kend[8 + 2 * e], kend[8 + 2 * e + 1]); }
    *(u32x4*)(kT + d * 40 + jb * 16) = k0; *(u32x4*)(kT + d * 40 + jb * 16 + 8) = k1;
  }
  const int vcol = IS_GLA ? ZC_GV : (ZC_HI + half * 256);
  {
    constexpr int NBATCH = NV / 256;
    const int v = tid % NV, jbase = (tid / NV) * 16;
#pragma unroll 1
    for (int bb = 0; bb < NBATCH; ++bb) {
      const int j0 = jbase + bb * 16;
      bf16_t raw[16];
#pragma unroll
      for (int i = 0; i < 16; ++i) raw[i] = u.z[(size_t)(j0 + i) * ZW + vcol + v];
      u32x4 w0, w1;
#pragma unroll
      for (int e = 0; e < 4; ++e) {
        const unsigned a0 = (j0 + 2 * e >= u.pad) ? raw[2 * e] : 0u, a1 = (j0 + 2 * e + 1 >= u.pad) ? raw[2 * e + 1] : 0u;
        const unsigned b0 = (j0 + 8 + 2 * e >= u.pad) ? raw[8 + 2 * e] : 0u, b1 = (j0 + 8 + 2 * e + 1 >= u.pad) ? raw[8 + 2 * e + 1] : 0u;
        w0[e] = a0 | (a1 << 16); w1[e] = b0 | (b1 << 16);
      }
      *(u32x4*)(vT + v * 40 + j0) = w0; *(u32x4*)(vT + v * 40 + j0 + 8) = w1;
    }
  }
  __syncthreads();
  {
    bf16_t* qkb = qk_block<IS_GLA>(p, u, half);
    const bf16_t* QL = (const bf16_t*)(smem + 96256); const bf16_t* KL = (const bf16_t*)(smem + 113152);
#pragma unroll
    for (int uu2 = 0; uu2 < 2; ++uu2) {
      const int c = tid + NTHR * uu2, row = c >> 5, chk = c & 31;
      *(u32x4*)(qkb + c * 8) = *(const u32x4*)(QL + row * 264 + chk * 8);
      *(u32x4*)(qkb + 8192 + c * 8) = *(const u32x4*)(KL + row * 264 + chk * 8);
    }
  }
  bf16_t* kvbase = IS_GLA ? u.kvA : (u.kvB + (size_t)half * 2 * 128 * 128);
#pragma unroll 1
  for (int tu = 0; tu < 4; ++tu) {
    const int tt = w * 4 + tu;
    const int dkt = tt % DKT, vt = (tt / DKT) % 4, hd = tt / (4 * DKT);
    f32x16 acc = zero16();
#pragma unroll
    for (int ks = 0; ks < 2; ++ks) {
      const bf16x8 a = *(const bf16x8*)(vT + (hd * 128 + vt * 32 + r) * 40 + ks * 16 + 8 * h);
      const bf16x8 b = *(const bf16x8*)(kT + (hd * DK + dkt * 32 + r) * 40 + ks * 16 + 8 * h);
      acc = MFMA32(b, a, acc);
    }
    bf16_t* dst = kvbase + ((size_t)hd * 128 + vt * 32 + r) * DK + dkt * 32 + 4 * h;
#pragma unroll
    for (int q = 0; q < 4; ++q) {
      u32x2 o; o[0] = pk2(acc[4 * q], acc[4 * q + 1]); o[1] = pk2(acc[4 * q + 2], acc[4 * q + 3]);
      *(u32x2*)(dst + 8 * q) = o;
    }
  }
  __syncthreads();
}

template <bool IS_GLA>
DI void gla_out(const Params& p, const UnitD& u, int l, int half, char* smem) {
  constexpr int NH = IS_GLA ? 4 : 2, DK = IS_GLA ? 64 : 128, NV = NH * 128, WPH = 8 / NH, VTP = 4 / WPH, KS = DK / 16;
  float* Gs = (float*)smem; float* lrs = (float*)(smem + 32768);
  bf16_t* qd = (bf16_t*)(smem + 34816); bf16_t* ki = (bf16_t*)(smem + 51712); bf16_t* vT = (bf16_t*)(smem + 68608);
  float* part = (float*)(smem + 109568);
  const int tid = opq((int)threadIdx.x), lane = tid & 63, w = tid >> 6, r = lane & 31, h = lane >> 5;
  (void)Gs; (void)lrs;
  bf16_t* GT = (bf16_t*)(smem + 112640);
  {
    const int gcol0 = IS_GLA ? ZC_GG : (ZC_HG + half * 256);
    constexpr int CPR = NV / 8, NCK = 32 * CPR / NTHR;
    u32x4 gt[NCK];
#pragma unroll
    for (int uu2 = 0; uu2 < NCK; ++uu2) { const int c = tid + NTHR * uu2, row = c / CPR, chk = c % CPR; gt[uu2] = *(const u32x4*)(u.z + (size_t)row * ZW + gcol0 + chk * 8); }
#pragma unroll
    for (int uu2 = 0; uu2 < NCK; ++uu2) { const int c = tid + NTHR * uu2, row = c / CPR, chk = c % CPR; *(u32x4*)(GT + row * (NV + 8) + chk * 8) = gt[uu2]; }
  }
  {
    const bf16_t* qkb = qk_block<IS_GLA>(p, u, half);
    u32x4 t0[2], t1[2];
#pragma unroll
    for (int uu2 = 0; uu2 < 2; ++uu2) { const int q = tid + NTHR * uu2; t0[uu2] = *(const u32x4*)(qkb + q * 8); t1[uu2] = *(const u32x4*)(qkb + 8192 + q * 8); }
#pragma unroll
    for (int uu2 = 0; uu2 < 2; ++uu2) { const int q = tid + NTHR * uu2, row = q >> 5, ch = q & 31; *(u32x4*)(qd + row * 264 + ch * 8) = t0[uu2]; *(u32x4*)(ki + row * 264 + ch * 8) = t1[uu2]; }
  }
  const int vcol = IS_GLA ? ZC_GV : (ZC_HI + half * 256);
  {
    constexpr int NBATCH = NV / 256;
    const int v = tid % NV, jbase = (tid / NV) * 16;
#pragma unroll 1
    for (int bb = 0; bb < NBATCH; ++bb) {
      const int j0 = jbase + bb * 16;
      bf16_t raw[16];
#pragma unroll
      for (int i = 0; i < 16; ++i) raw[i] = u.z[(size_t)(j0 + i) * ZW + vcol + v];
      u32x4 w0, w1;
#pragma unroll
      for (int e = 0; e < 4; ++e) {
        const unsigned a0 = (j0 + 2 * e >= u.pad) ? raw[2 * e] : 0u, a1 = (j0 + 2 * e + 1 >= u.pad) ? raw[2 * e + 1] : 0u;
        const unsigned b0 = (j0 + 8 + 2 * e >= u.pad) ? raw[8 + 2 * e] : 0u, b1 = (j0 + 8 + 2 * e + 1 >= u.pad) ? raw[8 + 2 * e + 1] : 0u;
        w0[e] = a0 | (a1 << 16); w1[e] = b0 | (b1 << 16);
      }
      *(u32x4*)(vT + v * 40 + j0) = w0; *(u32x4*)(vT + v * 40 + j0 + 8) = w1;
    }
  }
  __syncthreads();
  const int hd = w / WPH, sub = w % WPH;
  const int hdg = IS_GLA ? hd : (half * 2 + hd);
  f32x16 X = zero16();
#pragma unroll
  for (int ks = 0; ks < KS; ++ks) {
    const bf16x8 a = *(const bf16x8*)(ki + r * 264 + hd * DK + ks * 16 + 8 * h);
    const bf16x8 b = *(const bf16x8*)(qd + r * 264 + hd * DK + ks * 16 + 8 * h);
    X = MFMA32(a, b, X);
  }
#pragma unroll
  for (int reg = 0; reg < 16; ++reg) if (crow(reg, h) > r) X[reg] = 0.f;
  bf16x8 xs[2];
  xs[0] = pack8(X[0], X[1], X[2], X[3], X[4], X[5], X[6], X[7]);
  xs[1] = pack8(X[8], X[9], X[10], X[11], X[12], X[13], X[14], X[15]);
  f32x16 o[VTP];
  const bf16_t* Sbase = (IS_GLA ? u.sA : u.sB) + (size_t)hdg * 128 * DK;
#pragma unroll
  for (int vt = 0; vt < VTP; ++vt) {
    const int vg = sub * VTP + vt;
    o[vt] = zero16();
#pragma unroll
    for (int st = 0; st < 2; ++st) {
      const bf16x4 lo = *(const bf16x4*)(vT + (hd * 128 + vg * 32 + r) * 40 + 16 * st + 4 * h);
      const bf16x4 hi = *(const bf16x4*)(vT + (hd * 128 + vg * 32 + r) * 40 + 16 * st + 8 + 4 * h);
      const bf16x8 pb = __builtin_shufflevector(lo, hi, 0, 1, 2, 3, 4, 5, 6, 7);
      o[vt] = MFMA32(xs[st], pb, o[vt]);
    }
    if (!u.meta) {
      const bf16_t* Sp = Sbase + (size_t)(vg * 32 + r) * DK + 8 * h;
      bf16x8 sb[KS];
#pragma unroll
      for (int ks = 0; ks < KS; ++ks) sb[ks] = *(const bf16x8*)(Sp + ks * 16);
#pragma unroll
      for (int ks = 0; ks < KS; ++ks) {
        const bf16x8 a = *(const bf16x8*)(qd + r * 264 + hd * DK + ks * 16 + 8 * h);
        o[vt] = MFMA32(a, sb[ks], o[vt]);
      }
    }
  }
#pragma unroll
  for (int reg = 0; reg < 16; ++reg) {
    float s = 0.f;
#pragma unroll
    for (int vt = 0; vt < VTP; ++vt) s += o[vt][reg] * o[vt][reg];
#pragma unroll
    for (int off = 1; off < 32; off <<= 1) s += __shfl_xor(s, off);
    if (r == 0) part[w * 32 + crow(reg, h)] = s;
  }
  __syncthreads();
  const float* gn = (IS_GLA ? p.gnorm : p.hnorm) + (l * 4 + hdg) * 128;
  const int yoff = IS_GLA ? 0 : (512 + half * 256);
#pragma unroll
  for (int reg = 0; reg < 16; ++reg) {
    const int c = crow(reg, h);
    float tot = 0.f;
#pragma unroll
    for (int ww = 0; ww < WPH; ++ww) tot += part[(hd * WPH + ww) * 32 + c];
    const float rsq = rsqrtf(tot * (1.f / 128.f) + EPS);
#pragma unroll
    for (int vt = 0; vt < VTP; ++vt) {
      const int v = (sub * VTP + vt) * 32 + r;
      bf16_t* gp = GT + c * (NV + 8) + hd * 128 + v;
      const float gate = bf2f(*gp);
      *gp = f2bf(o[vt][reg] * rsq * gn[v] * siluf_(gate));
    }
  }
  __syncthreads();
  {
    constexpr int CPR = NV / 8, NCK = 32 * CPR / NTHR;
#pragma unroll
    for (int uu2 = 0; uu2 < NCK; ++uu2) {
      const int c = tid + NTHR * uu2, row = c / CPR, chk = c % CPR;
      *(u32x4*)(u.ys + (size_t)row * 2048 + yoff + chk * 8) = *(const u32x4*)(GT + row * (NV + 8) + chk * 8);
    }
  }
  __syncthreads();
}

DI void lru_local(const Params& p, const UnitD& u, int l, char* smem) {
  float* XC = (float*)smem;
  bf16_t* XCb = (bf16_t*)(smem + 33280);
  float* LA = (float*)(smem + 50176);
  const int tid = opq((int)threadIdx.x), lane = tid & 63, w = tid >> 6, r = lane & 31, h = lane >> 5;
#pragma unroll 1
  for (int hf = 0; hf < 2; ++hf) {
    {
      const int n = tid & 255, jh = tid >> 8, ch = hf * 256 + n, j0 = jh * 16;
      const float w0 = p.convw[(l * 4 + 0) * 512 + ch], w1 = p.convw[(l * 4 + 1) * 512 + ch], w2 = p.convw[(l * 4 + 2) * 512 + ch],
                  w3 = p.convw[(l * 4 + 3) * 512 + ch], cb = p.convb[l * 512 + ch];
      bf16_t xr[19];
#pragma unroll
      for (int i = 0; i < 19; ++i) {
        if (i < 3 && j0 == 0) xr[i] = u.halo ? u.halo[(size_t)i * ZW + ZC_LX + ch] : (bf16_t)0;
        else xr[i] = u.z[(size_t)(j0 - 3 + i) * ZW + ZC_LX + ch];
      }
      float x3 = bf2f(xr[0]), x2 = bf2f(xr[1]), x1 = bf2f(xr[2]);
#pragma unroll
      for (int jj = 0; jj < 16; ++jj) {
        const int j = j0 + jj;
        const float x0 = bf2f(xr[3 + jj]);
        const float xc = cb + w0 * x0 + w1 * x1 + w2 * x2 + w3 * x3;
        XC[j * 260 + n] = xc; XCb[j * 264 + n] = f2bf(xc);
        x3 = x2; x2 = x1; x1 = x0;
      }
    }
    __syncthreads();
    {
      const int blk = w >> 1, nt = w & 1, blkg = hf * 4 + blk;
      const bf16_t* wa = P_waT + ((size_t)(l * 8 + blkg) * 64 + nt * 32 + r) * 64 + 8 * h;
      const bf16_t* wx = P_wxT + ((size_t)(l * 8 + blkg) * 64 + nt * 32 + r) * 64 + 8 * h;
      f32x16 aa = zero16(), ax = zero16();
#pragma unroll
      for (int ks = 0; ks < 4; ++ks) {
        const bf16x8 a1 = *(const bf16x8*)(wa + ks * 16), a2 = *(const bf16x8*)(wx + ks * 16);
        const bf16x8 b = *(const bf16x8*)(XCb + r * 264 + blk * 64 + ks * 16 + 8 * h);
        aa = MFMA32(a1, b, aa); ax = MFMA32(a2, b, ax);
      }
#pragma unroll
      for (int q = 0; q < 4; ++q) {
        const int nn = blk * 64 + nt * 32 + 8 * q + 4 * h, chg = hf * 256 + nn;
        f32x4 xc = *(const f32x4*)(XC + r * 260 + nn);
        f32x4 av, iv;
#pragma unroll
        for (int i = 0; i < 4; ++i) {
          const float rr = sigmoidf_(aa[4 * q + i] + p.ba[l * 512 + chg + i]);
          const float ig = sigmoidf_(ax[4 * q + i] + p.bx[l * 512 + chg + i]);
          const float la = -8.f * rr * softplusf_(-p.lam[l * 512 + chg + i]);
          float a = __expf(la), inp = __builtin_amdgcn_sqrtf(fmaxf(1.f - __expf(2.f * la), 0.f)) * ig * xc[i];
          if (r < u.pad) { a = 1.f; inp = 0.f; }
          av[i] = a; iv[i] = inp;
        }
        *(f32x4*)(LA + r * 260 + nn) = av; *(f32x4*)(XC + r * 260 + nn) = iv;
      }
    }
    __syncthreads();
    if (tid < 256) {
      const int n = tid, ch = hf * 256 + n;
      float hh = 0.f, A = 1.f;
      for (int j = 0; j < 32; ++j) {
        const float a = LA[j * 260 + n], xv = XC[j * 260 + n];
        hh = a * hh + xv; A *= a;
        u.hloc[(size_t)j * 512 + ch] = f2bf(hh); u.cumA[(size_t)j * 512 + ch] = f2bf(A);
      }
      if (u.cha) u.cha[ch] = A;
      u.chh[ch] = hh;
    }
    __syncthreads();
  }
}

DI void lru_out(const Params& p, const UnitD& u, char* smem) {
  const int tid = opq((int)threadIdx.x);
  u32x4 hv[4], av[4], gv[4];
#pragma unroll
  for (int it = 0; it < 4; ++it) {
    const int idx = tid + NTHR * it, j = idx >> 6, c8 = idx & 63;
    hv[it] = *(const u32x4*)(u.hloc + (size_t)j * 512 + c8 * 8);
    av[it] = *(const u32x4*)(u.cumA + (size_t)j * 512 + c8 * 8);
    gv[it] = *(const u32x4*)(u.z + (size_t)j * ZW + ZC_LG + c8 * 8);
  }
#pragma unroll
  for (int it = 0; it < 4; ++it) {
    const int idx = tid + NTHR * it, j = idx >> 6, c8 = idx & 63;
    float ci[8];
#pragma unroll
    for (int e = 0; e < 8; ++e) ci[e] = u.cin ? u.cin[c8 * 8 + e] : 0.f;
    u32x4 o;
#pragma unroll
    for (int e = 0; e < 4; ++e) {
      float r2[2];
#pragma unroll
      for (int k = 0; k < 2; ++k) {
        const float hh = bf2f((bf16_t)(hv[it][e] >> (16 * k))), aa = bf2f((bf16_t)(av[it][e] >> (16 * k))), gt = bf2f((bf16_t)(gv[it][e] >> (16 * k)));
        r2[k] = (hh + aa * ci[2 * e + k]) * siluf_(gt);
      }
      o[e] = pk2(r2[0], r2[1]);
    }
    *(u32x4*)(u.ys + (size_t)j * 2048 + 1536 + c8 * 8) = o;
  }
}

DI void s5_item(const Params& p, int l, int grp, int bl, int gs, char* smem) {
  bf16_t* Ub = (bf16_t*)smem;
  float* E = (float*)(smem + 41472);
  char* FT = smem + 110112;
  const int tid = opq((int)threadIdx.x), lane = tid & 63, w = tid >> 6, r = lane & 31, h = lane >> 5;
  const int lg = l * 32 + gs;
  const bf16_t* Pg = P_PS + (size_t)lg * 128 * 512;
  const bf16_t* TMg = P_TM + (size_t)lg * 512 * 640;
  const bool wmeta = (grp == 0 && bl == 0);
  auto load_U = [&](int ut) {
#pragma unroll
    for (int it = 0; it < 4; ++it) {
      const int idx = tid + NTHR * it, m = idx >> 6, rem = idx & 63, s = rem >> 1, hv = rem & 1, uu = ut * 32 + m;
      u32x4 val = {0u, 0u, 0u, 0u};
      if (uu <= NCH) {
        const bf16_t* zr = (uu == 0) ? P_zm : (P_zg + ((size_t)bl * SEQ + (uu - 1) * 32) * ZW);
        val = *(const u32x4*)(zr + (size_t)s * ZW + ZC_SU + gs * 16 + hv * 8);
      }
      *(u32x4*)(Ub + m * 648 + s * 16 + hv * 8) = val;
    }
  };
  for (int idx = tid; idx < 33 * 64; idx += NTHR) {
    const int di = idx >> 6, ln = idx & 63, d = di - 1, rt0 = (d + (d & 1)) >> 1, ks0 = d & 1;
    *(u32x4*)(FT + di * 1024 + ln * 16) = *(const u32x4*)(TMg + (size_t)(rt0 * 32 + (ln & 31)) * 640 + ks0 * 16 + 8 * (ln >> 5));
  }
#pragma unroll 1
  for (int ut = 0; ut < 5; ++ut) {
    load_U(ut);
    __syncthreads();
    const int nt = w & 3, kh = w >> 2;
    f32x16 acc = zero16();
#pragma unroll 8
    for (int kk = 0; kk < 16; ++kk) {
      const int ks = kh * 16 + kk;
      const bf16x8 a = *(const bf16x8*)(Pg + (size_t)(nt * 32 + r) * 512 + ks * 16 + 8 * h);
      const bf16x8 b = *(const bf16x8*)(Ub + r * 648 + ks * 16 + 8 * h);
      acc = MFMA32(a, b, acc);
    }
    float* er = E + (ut * 32 + r) * 132 + nt * 32 + 4 * h;
    const bool uok = (ut * 32 + r) < 130;
    if (kh == 1 && uok) {
#pragma unroll
      for (int q = 0; q < 4; ++q) { f32x4 v = {acc[4 * q], acc[4 * q + 1], acc[4 * q + 2], acc[4 * q + 3]}; *(f32x4*)(er + 8 * q) = v; }
    }
    __syncthreads();
    if (kh == 0 && uok) {
#pragma unroll
      for (int q = 0; q < 4; ++q) {
        f32x4 v = *(const f32x4*)(er + 8 * q);
        v[0] += acc[4 * q]; v[1] += acc[4 * q + 1]; v[2] += acc[4 * q + 2]; v[3] += acc[4 * q + 3];
        *(f32x4*)(er + 8 * q) = v;
      }
    }
    __syncthreads();
  }
  if (tid < 64) {
    const int n = tid;
    const float ar = P_AL[(lg * 64 + n) * 2], ai = P_AL[(lg * 64 + n) * 2 + 1];
    float hr = 0.f, hi = 0.f;
    for (int uu = 0; uu <= NCH; ++uu) {
      const float er = E[uu * 132 + n], ei = E[uu * 132 + 64 + n];
      E[uu * 132 + n] = hr; E[uu * 132 + 64 + n] = hi;
      const float nhr = ar * hr - ai * hi + er, nhi = ar * hi + ai * hr + ei;
      hr = nhr; hi = nhi;
    }
  }
  __syncthreads();
#pragma unroll 1
  for (int ut = 0; ut < 5; ++ut) {
    load_U(ut);
    for (int idx = tid; idx < 32 * 128; idx += NTHR) {
      const int m = idx >> 7, kk = idx & 127;
      Ub[m * 648 + 512 + kk] = ((ut * 32 + m) < 130) ? f2bf(E[(ut * 32 + m) * 132 + kk]) : (bf16_t)0;
    }
    __syncthreads();
    f32x16 acc0 = zero16(), acc1 = zero16();
    const bf16_t* a0p = TMg + (size_t)(w * 32 + r) * 640 + 8 * h;
    const bf16_t* a1p = TMg + (size_t)((15 - w) * 32 + r) * 640 + 8 * h;
    const bf16_t* bp = Ub + r * 648 + 8 * h;
    {
      const int n0 = 2 * w + 2;
      const char* f0 = FT + (2 * w + 1) * 1024 + lane * 16;
#pragma unroll 2
      for (int ks = 0; ks < n0; ++ks) acc0 = MFMA32(*(const bf16x8*)(f0 - ks * 1024), *(const bf16x8*)(bp + ks * 16), acc0);
      const int n1 = 32 - 2 * w;
      const char* f1 = FT + (2 * (15 - w) + 1) * 1024 + lane * 16;
#pragma unroll 2
      for (int ks = 0; ks < n1; ++ks) acc1 = MFMA32(*(const bf16x8*)(f1 - ks * 1024), *(const bf16x8*)(bp + ks * 16), acc1);
#pragma unroll
      for (int ks = 32; ks < 40; ++ks) {
        const bf16x8 b = *(const bf16x8*)(bp + ks * 16);
        acc0 = MFMA32(*(const bf16x8*)(a0p + ks * 16), b, acc0); acc1 = MFMA32(*(const bf16x8*)(a1p + ks * 16), b, acc1);
      }
    }
    const int uu = ut * 32 + r;
    if (uu <= NCH && (uu > 0 || wmeta)) {
      bf16_t* yrow = (uu == 0) ? P_ygm : (P_ygg + ((size_t)bl * SEQ + (uu - 1) * 32) * 512);
#pragma unroll
      for (int rr = 0; rr < 2; ++rr) {
        const int rt = rr ? (15 - w) : w;
#pragma unroll
        for (int q = 0; q < 4; ++q) {
          const int j = rt * 2 + (q >> 1), c = 8 * (q & 1) + 4 * h, ch = gs * 16 + c;
          float yv[4];
#pragma unroll
          for (int i = 0; i < 4; ++i) {
            const float av = rr ? acc1[4 * q + i] : acc0[4 * q + i];
            const float uv = bf2f(Ub[r * 648 + j * 16 + c + i]);
            yv[i] = geluf_(av + p.s5d[l * 512 + ch + i] * uv);
          }
          u32x2 o; o[0] = pk2(yv[0], yv[1]); o[1] = pk2(yv[2], yv[3]);
          *(u32x2*)(yrow + (size_t)j * 512 + ch) = o;
        }
      }
    }
    __syncthreads();
  }
}

DI void gemm1_small_tile(const Params& p, int l, const bf16_t* A, bf16_t* out, const float* ss, int nt, char* smem) {
  const int tid = opq((int)threadIdx.x), lane = tid & 63, w = tid >> 6, r = lane & 31, h = lane >> 5, wm = w & 3, wn = w >> 2;
  f32x16 acc[2][2];
#pragma unroll
  for (int i = 0; i < 2; ++i) for (int j = 0; j < 2; ++j) acc[i][j] = zero16();
  gemm_main(A, DM, P_WinT + ((size_t)l * ZW + nt * 128) * DM, DM, DM, smem, acc);
#pragma unroll
  for (int j = 0; j < 2; ++j) {
    const int m = wm * 64 + j * 32 + r;
    const float rs = rsqrtf(ss[m] * (1.f / DM) + EPS);
#pragma unroll
    for (int i = 0; i < 2; ++i)
#pragma unroll
      for (int q = 0; q < 4; ++q) {
        const int n = nt * 128 + wn * 64 + i * 32 + 8 * q + 4 * h;
        u32x2 o; o[0] = pk2(acc[i][j][4 * q] * rs, acc[i][j][4 * q + 1] * rs); o[1] = pk2(acc[i][j][4 * q + 2] * rs, acc[i][j][4 * q + 3] * rs);
        *(u32x2*)(out + (size_t)m * ZW + n) = o;
      }
  }
}

DI void phase_gemm1(const Params& p, int l, int g, char* smem) {
  const int tid = opq((int)threadIdx.x), lane = tid & 63, w = tid >> 6, r = lane & 31, h = lane >> 5;
  const int bid = blockIdx.x, nb = gridDim.x;
  constexpr int NBIG = 32 * 38;
  for (int t = bid; t < NBIG; t += nb) {
    const int mt = t & 31, nt2 = t >> 5;
    const bf16_t* A = P_hb + ((size_t)g * RG + mt * 256) * DM;
    bf16_t* out = P_zg + (size_t)mt * 256 * ZW;
    const float* ss = P_ss + l * NROWS + g * RG + mt * 256;
    f32x16 acc[2][4];
#pragma unroll
    for (int i = 0; i < 2; ++i) for (int j = 0; j < 4; ++j) acc[i][j] = zero16();
    gemm_main_256(A, DM, P_WinT + ((size_t)l * ZW + nt2 * 256) * DM, DM, DM, smem, acc);
    const int wm = w & 1, wn = w >> 1;
#pragma unroll
    for (int j = 0; j < 4; ++j) {
      const int m = wm * 128 + j * 32 + r;
      const float rs = rsqrtf(ss[m] * (1.f / DM) + EPS);
#pragma unroll
      for (int i = 0; i < 2; ++i)
#pragma unroll
        for (int q = 0; q < 4; ++q) {
          const int n = nt2 * 256 + wn * 64 + i * 32 + 8 * q + 4 * h;
          u32x2 o; o[0] = pk2(acc[i][j][4 * q] * rs, acc[i][j][4 * q + 1] * rs); o[1] = pk2(acc[i][j][4 * q + 2] * rs, acc[i][j][4 * q + 3] * rs);
          *(u32x2*)(out + (size_t)m * ZW + n) = o;
        }
    }
  }
  const int nsmall = 32 + (g == 0 ? 77 : 0);
  const int first = (nb > 192) ? 192 : 0, nw = nb - first;
  if (bid >= first) {
    for (int s = bid - first; s < nsmall; s += nw) {
      if (s < 32) gemm1_small_tile(p, l, P_hb + ((size_t)g * RG + s * 256) * DM, P_zg + (size_t)s * 256 * ZW, P_ss + l * NROWS + g * RG + s * 256, 76, smem);
      else gemm1_small_tile(p, l, P_hb + (size_t)MROW0 * DM, P_zm, P_ss + l * NROWS + MROW0, s - 32, smem);
    }
  }
}

DI int grab_item(unsigned* ctr, char* smem) {
  volatile int* slot = (volatile int*)(smem + LDS_BYTES - 16);
  __syncthreads();
  if (threadIdx.x == 0) *slot = (int)__hip_atomic_fetch_add(ctr, 1u, __ATOMIC_RELAXED, __HIP_MEMORY_SCOPE_AGENT);
  __syncthreads();
  return *slot;
}

DI void phase_local(const Params& p, int l, int g, char* smem) {
  unsigned* ctr = P_ctrl + 64 + ((l * NGRP + g) * 2 + 0) * 16;
  const int nun = NUNIT + (g == 0 ? 1 : 0);
  const int nitem = NB * 32 + nun * 4;
  for (;;) {
    const int it = grab_item(ctr, smem);
    if (it >= nitem) break;
    if (it < NB * 32) { s5_item(p, l, g, it >> 5, it & 31, smem); continue; }
    const int s = it - NB * 32;
    const int uu = s >> 2, ty = s & 3;
    const UnitD u = make_unit(p, uu);
    if (ty == 0) gla_local<true>(p, u, l, 0, smem);
    else if (ty == 1) gla_local<false>(p, u, l, 0, smem);
    else if (ty == 2) gla_local<false>(p, u, l, 1, smem);
    else lru_local(p, u, l, smem);
  }
}

DI void glu_tile(const Params& p, int l, int bid, char* smem) {
  const int tid = opq((int)threadIdx.x), lane = tid & 63, w = tid >> 6, r = lane & 31, h = lane >> 5, wm = w & 3, wn = w >> 2;
  {
    const bf16_t* A; const bf16_t* zz; bf16_t* ys; int nt;
    if (bid < 128) { const int mt = bid & 31; nt = bid >> 5; A = P_ygg + (size_t)mt * 256 * 512; zz = P_zg + (size_t)mt * 256 * ZW; ys = P_ysg + (size_t)mt * 256 * 2048; }
    else { nt = bid - 128; A = P_ygm; zz = P_zm; ys = P_ysm; }
    f32x16 acc[2][2];
#pragma unroll
    for (int i = 0; i < 2; ++i) for (int j = 0; j < 2; ++j) acc[i][j] = zero16();
    gemm_main(A, 512, P_gluT + ((size_t)l * 512 + nt * 128) * 512, 512, 512, smem, acc, bid >= 128);
#pragma unroll
    for (int j = 0; j < 2; ++j) {
      const int m = wm * 64 + j * 32 + r;
#pragma unroll
      for (int i = 0; i < 2; ++i)
#pragma unroll
        for (int q = 0; q < 4; ++q) {
          const int n = nt * 128 + wn * 64 + i * 32 + 8 * q + 4 * h;
          const u32x2 yv = *(const u32x2*)(A + (size_t)m * 512 + n);
          const u32x2 gv = *(const u32x2*)(zz + (size_t)m * ZW + ZC_SG + n);
          float o4[4];
#pragma unroll
          for (int e = 0; e < 4; ++e) {
            const float y = bf2f((bf16_t)(yv[e >> 1] >> (16 * (e & 1))));
            const float gt = bf2f((bf16_t)(gv[e >> 1] >> (16 * (e & 1))));
            o4[e] = y * sigmoidf_(acc[i][j][4 * q + e] + p.glub[l * 512 + n + e]) * siluf_(gt);
          }
          u32x2 o; o[0] = pk2(o4[0], o4[1]); o[1] = pk2(o4[2], o4[3]);
          *(u32x2*)(ys + (size_t)m * 2048 + 1024 + n) = o;
        }
    }
  }
}

DI void phase_scan_states(const Params& p, int l, int g) {
  const int tid = opq((int)threadIdx.x), bid = blockIdx.x;
  typedef float f32x2 __attribute__((ext_vector_type(2)));
  if (tid < 384) {
    const int e = bid * 384 + tid;
    const bf16_t* pk; bf16_t* ps; const float* dec; const bf16_t* init; size_t pstride; int dstride;
    if (e < 32768) {
      const int bl = e / 16384, rem = e % 16384, el = rem * 2, hd = el / 8192, dk = el % 64;
      pk = (const bf16_t*)P_kvA + (size_t)bl * NCH * 32768 + el; ps = (bf16_t*)P_kvA + (size_t)(NUNIT + bl * NCH) * 32768 + el; pstride = 32768;
      init = (const bf16_t*)P_kvAm + el;
      dec = P_decA + (size_t)bl * NCH * 256 + hd * 64 + dk; dstride = 256;
    } else {
      const int e2 = e - 32768, bl = e2 / 32768, rem = e2 % 32768, el = rem * 2, hd = el / 16384, dk = el % 128;
      pk = (const bf16_t*)P_kvB + (size_t)bl * NCH * 65536 + el; ps = (bf16_t*)P_kvB + (size_t)(NUNIT + bl * NCH) * 65536 + el; pstride = 65536;
      init = (const bf16_t*)P_kvBm + el;
      dec = P_decB + (size_t)bl * NCH * 512 + hd * 128 + dk; dstride = 512;
    }
    f32x2 s;
    { const unsigned iv = *(const unsigned*)init; s[0] = bf2f((bf16_t)iv); s[1] = bf2f((bf16_t)(iv >> 16)); }
#pragma unroll 1
    for (int c0 = 0; c0 < NCH; c0 += SCAN_U) {
      unsigned cur[SCAN_U]; f32x2 dd[SCAN_U];
#pragma unroll
      for (int i = 0; i < SCAN_U; ++i) { cur[i] = __builtin_nontemporal_load((const unsigned*)(pk + (size_t)(c0 + i) * pstride)); dd[i] = *(const f32x2*)(dec + (size_t)(c0 + i) * dstride); }
#pragma unroll
      for (int i = 0; i < SCAN_U; ++i) {
        *(unsigned*)(ps + (size_t)(c0 + i) * pstride) = pk2(s[0], s[1]);
        s[0] = dd[i][0] * s[0] + bf2f((bf16_t)cur[i]);
        s[1] = dd[i][1] * s[1] + bf2f((bf16_t)(cur[i] >> 16));
      }
    }
  } else if (bid < 8) {
    const int e = bid * 128 + (tid - 384), bl = e >> 9, n = e & 511;
    float carry = P_chhm[n];
#pragma unroll 8
    for (int c = 0; c < NCH; ++c) {
      const int ix = (bl * NCH + c) * 512 + n;
      const float a = P_cha[ix], hh = P_chh[ix];
      P_cin[ix] = carry;
      carry = a * carry + hh;
    }
  }
}

DI void phase_output(const Params& p, int l, int g, char* smem) {
  unsigned* ctr = P_ctrl + 64 + ((l * NGRP + g) * 2 + 1) * 16;
  const int nun = NUNIT + (g == 0 ? 1 : 0);
  const int nglu = 128 + (g == 0 ? 4 : 0);
  for (;;) {
    int s = grab_item(ctr, smem);
    if (s >= nglu + nun * 4) break;
    if (s < nglu) { glu_tile(p, l, s, smem); continue; }
    s -= nglu;
    const int ty = s / nun, uu = s % nun;
    const UnitD u = make_unit(p, uu);
    if (ty == 0) gla_out<true>(p, u, l, 0, smem);
    else if (ty == 1) gla_out<false>(p, u, l, 0, smem);
    else if (ty == 2) gla_out<false>(p, u, l, 1, smem);
    else lru_out(p, u, smem);
  }
}

DI void phase_gemm2(const Params& p, int l, int g, char* smem) {
  const int tid = opq((int)threadIdx.x), lane = tid & 63, w = tid >> 6, r = lane & 31, h = lane >> 5, wm = w & 3, wn = w >> 2;
  const int ntile = 256 + (g == 0 ? 8 : 0);
  for (int t = blockIdx.x; t < ntile; t += gridDim.x) {
    const bf16_t* A; const bf16_t* zz; bf16_t* out; int nt;
    if (t < 256) { const int mt = t & 31; nt = t >> 5; A = P_ysg + (size_t)mt * 256 * 2048; zz = P_zg + (size_t)mt * 256 * ZW; out = P_mgd + (size_t)mt * 256 * DM; }
    else { nt = t - 256; A = P_ysm; zz = P_zm; out = P_mgdm; }
    f32x16 macc[2][2];
#pragma unroll
    for (int i = 0; i < 2; ++i) for (int j = 0; j < 2; ++j) macc[i][j] = zero16();
#pragma unroll 1
    for (int nb = 0; nb < 4; ++nb) {
      f32x16 acc[2][2];
#pragma unroll
      for (int i = 0; i < 2; ++i) for (int j = 0; j < 2; ++j) acc[i][j] = zero16();
      gemm_main(A + nb * 512, 2048, P_WbT + (((size_t)l * 4 + nb) * DM + nt * 128) * 512, 512, 512, smem, acc, t >= 256, zz + ZC_MG + nb * 1024 + nt * 128, ZW);
#pragma unroll
      for (int j = 0; j < 2; ++j) {
        const int m = wm * 64 + j * 32 + r;
#pragma unroll
        for (int i = 0; i < 2; ++i)
#pragma unroll
          for (int q = 0; q < 4; ++q) {
            const char* grow = (m < 192) ? (smem + 2 * 49152 + m * 256) : (smem + 0 * 49152 + (m - 192) * 256);
            const u32x2 gv = *(const u32x2*)(grow + (((wn * 8 + i * 4 + q) ^ (m & 15)) << 4) + 8 * h);
#pragma unroll
            for (int e = 0; e < 4; ++e) {
              const float gt = bf2f((bf16_t)(gv[e >> 1] >> (16 * (e & 1))));
              macc[i][j][4 * q + e] += sigmoidf_(gt) * acc[i][j][4 * q + e];
            }
          }
      }
    }
#pragma unroll
    for (int j = 0; j < 2; ++j) {
      const int m = wm * 64 + j * 32 + r;
#pragma unroll
      for (int i = 0; i < 2; ++i)
#pragma unroll
        for (int q = 0; q < 4; ++q) {
          const int n = nt * 128 + wn * 64 + i * 32 + 8 * q + 4 * h;
          u32x2 o; o[0] = pk2(macc[i][j][4 * q], macc[i][j][4 * q + 1]); o[1] = pk2(macc[i][j][4 * q + 2], macc[i][j][4 * q + 3]);
          *(u32x2*)(out + (size_t)m * DM + n) = o;
        }
    }
  }
}

DI void phase_gemm3(const Params& p, int l, int g, char* smem) {
  const int tid = opq((int)threadIdx.x), lane = tid & 63, w = tid >> 6, r = lane & 31, h = lane >> 5, wm = w & 3, wn = w >> 2;
  const int ntile = 256 + (g == 0 ? 8 : 0);
  for (int t = blockIdx.x; t < ntile; t += gridDim.x) {
    const bf16_t* A; const float* hin; float* hout; bf16_t* hb; float* ss; int nt;
    if (t < 256) {
      const int mt = t & 31; nt = t >> 5; const size_t row0 = (size_t)g * RG + mt * 256;
      A = P_mgd + (size_t)mt * 256 * DM; hin = (l == 0 ? p.x : p.out) + row0 * DM; hout = p.out + row0 * DM; hb = P_hb + row0 * DM; ss = P_ss + (l + 1) * NROWS + row0;
    } else { nt = t - 256; A = P_mgdm; hin = P_hmeta; hout = P_hmeta; hb = P_hb + (size_t)MROW0 * DM; ss = P_ss + (l + 1) * NROWS + MROW0; }
    f32x16 acc[2][2];
#pragma unroll
    for (int i = 0; i < 2; ++i) for (int j = 0; j < 2; ++j) acc[i][j] = zero16();
    f32x4 hpre[2][2][4];
#pragma unroll
    for (int j = 0; j < 2; ++j)
#pragma unroll
      for (int i = 0; i < 2; ++i)
#pragma unroll
        for (int q = 0; q < 4; ++q)
          hpre[j][i][q] = *(const f32x4*)(hin + (size_t)(wm * 64 + j * 32 + r) * DM + nt * 128 + wn * 64 + i * 32 + 8 * q + 4 * h);
    gemm_main(A, DM, P_WoutT + ((size_t)l * DM + nt * 128) * DM, DM, DM, smem, acc, t >= 256);
#pragma unroll
    for (int j = 0; j < 2; ++j) {
      const int m = wm * 64 + j * 32 + r;
      float sq = 0.f;
#pragma unroll
      for (int i = 0; i < 2; ++i)
#pragma unroll
        for (int q = 0; q < 4; ++q) {
          const int n = nt * 128 + wn * 64 + i * 32 + 8 * q + 4 * h;
          f32x4 hv = hpre[j][i][q];
#pragma unroll
          for (int e = 0; e < 4; ++e) { hv[e] += acc[i][j][4 * q + e]; sq += hv[e] * hv[e]; }
          *(f32x4*)(hout + (size_t)m * DM + n) = hv;
          if (l == 0) { u32x2 o; o[0] = pk2(hv[0], hv[1]); o[1] = pk2(hv[2], hv[3]); *(u32x2*)(hb + (size_t)m * DM + n) = o; }
        }
      sq += __shfl_xor(sq, 32);
      if (h == 0) atomicAdd(ss + m, sq);
    }
  }
}

DI void phase_final(const Params& p) {
  const int tid = opq((int)threadIdx.x), lane = tid & 63, gw = blockIdx.x * 8 + (tid >> 6), ngw = gridDim.x * 8;
  for (int row = gw; row < MROW0; row += ngw) {
    const float rs = rsqrtf(P_ss[2 * NROWS + row] * (1.f / DM) + EPS);
    float* o = p.out + (size_t)row * DM;
#pragma unroll
    for (int q = 0; q < 4; ++q) {
      f32x4 v = *(const f32x4*)(o + q * 256 + lane * 4);
      const f32x4 fn = *(const f32x4*)(p.fnorm + q * 256 + lane * 4);
      v = v * rs * fn;
      __builtin_nontemporal_store(v, (f32x4*)(o + q * 256 + lane * 4));
    }
  }
}

__global__ void __launch_bounds__(NTHR) hybrid_mega(Params p) {
  extern __shared__ __attribute__((aligned(16))) char smem[];
  cg::grid_group grid = cg::this_grid();
  unsigned epoch = xb_xcc_id();
  if (threadIdx.x == 0) {
    volatile __attribute__((address_space(3))) unsigned* st = (volatile __attribute__((address_space(3))) unsigned*)(unsigned)(LDS_BYTES - 32);
    st[0] = 0u; st[1] = 0u;
    (void)xb_add(&(P_ctrl + 1024)[XB_XCNT(epoch)], 1u);
  }
  __syncthreads();
  prologue(p, smem);
  grid.sync();
  phase_gemm1(p, 0, 0, smem); gbar(P_ctrl, epoch);
#pragma unroll 1
  for (int l = 0; l < 2; ++l) {
#pragma unroll 1
    for (int g = 0; g < NGRP; ++g) {
      phase_local(p, l, g, smem); gbar(P_ctrl, epoch);
      phase_scan_states(p, l, g); gbar(P_ctrl, epoch);
      phase_output(p, l, g, smem); gbar(P_ctrl, epoch);
      phase_gemm2(p, l, g, smem); gbar(P_ctrl, epoch);
      phase_gemm3(p, l, g, smem);
      {
        const int gn = (g + 1) % NGRP, ln = l + (g + 1) / NGRP;
        if (ln < 2) phase_gemm1(p, ln, gn, smem);
      }
      gbar(P_ctrl, epoch);
    }
  }
  phase_final(p);
}

extern "C" void kernel_launch(void* const* d_in, const int* in_sizes, int n_in, void* d_out, int out_size, void* d_ws, size_t ws_size, hipStream_t stream) {
  Params p;
  memset(&p, 0, sizeof(p));
  const float* const* in = (const float* const*)d_in;
  p.x = in[0]; p.meta = in[1]; p.lbl = in[2]; p.fnorm = in[3]; p.ng = in[4]; p.w_in = in[5]; p.w_br = in[6]; p.w_out = in[7];
  p.w_lr = in[8]; p.b_lr = in[9]; p.gnorm = in[10]; p.hnorm = in[11]; p.lam_re = in[12]; p.lam_im = in[13]; p.log_dt = in[14];
  p.b_re = in[15]; p.b_im = in[16]; p.c_re = in[17]; p.c_im = in[18]; p.s5d = in[19]; p.gluw = in[20]; p.glub = in[21];
  p.convw = in[22]; p.convb = in[23]; p.wa = in[24]; p.ba = in[25]; p.wx = in[26]; p.bx = in[27]; p.lam = in[28];
  p.out = (float*)d_out;
  p.ws = (char*)d_ws; const size_t off = WS_NEED;
  static int grid_blocks = 0;
  if (!grid_blocks) {
    if (off > ws_size) { fprintf(stderr, "kernel_launch: workspace too small: need %zu have %zu\n", off, ws_size); grid_blocks = -1; }
    else {
      int dev = 0, cus = 0, per_cu = 0;
      hipGetDevice(&dev);
      hipDeviceGetAttribute(&cus, hipDeviceAttributeMultiprocessorCount, dev);
      hipFuncSetAttribute((const void*)hybrid_mega, hipFuncAttributeMaxDynamicSharedMemorySize, LDS_BYTES);
      hipOccupancyMaxActiveBlocksPerMultiprocessor(&per_cu, hybrid_mega, NTHR, LDS_BYTES);
      if (per_cu < 1) { fprintf(stderr, "kernel_launch: occupancy query returned %d\n", per_cu); grid_blocks = -1; }
      else grid_blocks = cus;
    }
  }
  if (grid_blocks <= 0) return;
  hipMemsetAsync(p.ws + O_ctrl, 0, 20480, stream);
  void* args[] = {&p};
  hipError_t e = hipLaunchCooperativeKernel((void*)hybrid_mega, dim3(grid_blocks), dim3(NTHR), args, LDS_BYTES, stream);
  if (e != hipSuccess) fprintf(stderr, "cooperative launch failed: %s (grid %d)\n", hipGetErrorString(e), grid_blocks);
}
```

```cpp
#include <hip/hip_runtime.h>
#include <hip/hip_cooperative_groups.h>
#include <cstdio>
#include <cstdint>
#include <cstring>
namespace cg = cooperative_groups;

typedef unsigned short bf16_t;
typedef short bf16x8 __attribute__((ext_vector_type(8)));
typedef short bf16x4 __attribute__((ext_vector_type(4)));
typedef float f32x16 __attribute__((ext_vector_type(16)));
typedef float f32x4 __attribute__((ext_vector_type(4)));
typedef unsigned u32x4 __attribute__((ext_vector_type(4)));
typedef unsigned u32x2 __attribute__((ext_vector_type(2)));

#define DI __device__ __forceinline__
#define MFMA32(a, b, c) __builtin_amdgcn_mfma_f32_32x32x16_bf16((a), (b), (c), 0, 0, 0)

constexpr int DM = 1024, NBAT = 8, SEQ = 4096, NMETA = 16;
constexpr int NB = 2;
constexpr int NGRP = NBAT / NB;
constexpr int RG = NB * SEQ;
constexpr int NCH = SEQ / 32;
constexpr int NUNIT = NB * NCH;
constexpr int ZW = 9856;
constexpr int INW = 9744;
constexpr int ZC_GQ = 0, ZC_GK = 256, ZC_GV = 512, ZC_GG = 1024, ZC_HQ = 1536, ZC_HF = 2048, ZC_HI = 2560, ZC_HG = 3072,
              ZC_SU = 3584, ZC_SG = 4096, ZC_LX = 4608, ZC_LG = 5120, ZC_LR = 5632, ZC_MG = 5760;
constexpr int MROW0 = NBAT * SEQ;
constexpr int NROWS = MROW0 + 256;
constexpr float EPS = 1e-6f;
constexpr int LDS_BYTES = 147968;
constexpr int NTHR = 512;
#ifndef SCAN_U
#define SCAN_U 32
#endif

struct Params {
  const float *x, *meta, *lbl, *fnorm, *ng, *w_in, *w_br, *w_out, *w_lr, *b_lr, *gnorm, *hnorm;
  const float *lam_re, *lam_im, *log_dt, *b_re, *b_im, *c_re, *c_im, *s5d, *gluw, *glub;
  const float *convw, *convb, *wa, *ba, *wx, *bx, *lam;
  float* out;
  char* ws;
};
constexpr size_t al256(size_t x) { return (x + 255) & ~(size_t)255; }
constexpr size_t O_ctrl = 0;
constexpr size_t O_ss = O_ctrl + al256(20480);
constexpr size_t O_hmeta = O_ss + al256((size_t)3*NROWS*4);
constexpr size_t O_hb = O_hmeta + al256((size_t)256*DM*4);
constexpr size_t O_WinT = O_hb + al256((size_t)NROWS*DM*2);
constexpr size_t O_WbT = O_WinT + al256((size_t)2*ZW*DM*2);
constexpr size_t O_WoutT = O_WbT + al256((size_t)8*DM*512*2);
constexpr size_t O_gluT = O_WoutT + al256((size_t)2*DM*DM*2);
constexpr size_t O_waT = O_gluT + al256((size_t)2*512*512*2);
constexpr size_t O_wxT = O_waT + al256((size_t)16*4096*2);
constexpr size_t O_TM = O_wxT + al256((size_t)16*4096*2);
constexpr size_t O_PS = O_TM + al256((size_t)64*512*640*2);
constexpr size_t O_AL = O_PS + al256((size_t)64*128*512*2);
constexpr size_t O_zg = O_AL + al256((size_t)64*64*2*4);
constexpr size_t O_zm = O_zg + al256((size_t)RG*ZW*2);
constexpr size_t O_ysg = O_zm + al256((size_t)256*ZW*2);
constexpr size_t O_ysm = O_ysg + al256((size_t)RG*2048*2);
constexpr size_t O_mgd = O_ysm + al256((size_t)256*2048*2);
constexpr size_t O_mgdm = O_mgd + al256((size_t)RG*DM*2);
constexpr size_t O_ygg = O_mgdm + al256((size_t)256*DM*2);
constexpr size_t O_ygm = O_ygg + al256((size_t)RG*512*2);
constexpr size_t O_kvA = O_ygm + al256((size_t)256*512*2);
constexpr size_t O_kvB = O_kvA + al256((size_t)NUNIT*32768*4);
constexpr size_t O_kvAm = O_kvB + al256((size_t)NUNIT*65536*4);
constexpr size_t O_kvBm = O_kvAm + al256((size_t)32768*4);
constexpr size_t O_decA = O_kvBm + al256((size_t)65536*4);
constexpr size_t O_decB = O_decA + al256((size_t)NUNIT*256*4);
constexpr size_t O_hloc = O_decB + al256((size_t)NUNIT*512*4);
constexpr size_t O_cumA = O_hloc + al256((size_t)RG*512*2);
constexpr size_t O_hlocm = O_cumA + al256((size_t)RG*512*2);
constexpr size_t O_cumAm = O_hlocm + al256((size_t)32*512*2);
constexpr size_t O_cha = O_cumAm + al256((size_t)32*512*2);
constexpr size_t O_chh = O_cha + al256((size_t)NUNIT*512*4);
constexpr size_t O_cin = O_chh + al256((size_t)NUNIT*512*4);
constexpr size_t O_chhm = O_cin + al256((size_t)NUNIT*512*4);
constexpr size_t O_qkA = O_chhm + al256((size_t)512*4);
constexpr size_t O_qkm = O_qkA + al256((size_t)NUNIT*16384*2);
constexpr size_t WS_NEED = O_qkm + al256((size_t)3*16384*2);
static_assert(WS_NEED <= (size_t)536870912, "workspace budget");
#define P_ctrl ((unsigned*)(p.ws + O_ctrl))
#define P_ss ((float*)(p.ws + O_ss))
#define P_hmeta ((float*)(p.ws + O_hmeta))
#define P_hb ((bf16_t*)(p.ws + O_hb))
#define P_WinT ((bf16_t*)(p.ws + O_WinT))
#define P_WbT ((bf16_t*)(p.ws + O_WbT))
#define P_WoutT ((bf16_t*)(p.ws + O_WoutT))
#define P_gluT ((bf16_t*)(p.ws + O_gluT))
#define P_waT ((bf16_t*)(p.ws + O_waT))
#define P_wxT ((bf16_t*)(p.ws + O_wxT))
#define P_TM ((bf16_t*)(p.ws + O_TM))
#define P_PS ((bf16_t*)(p.ws + O_PS))
#define P_AL ((float*)(p.ws + O_AL))
#define P_zg ((bf16_t*)(p.ws + O_zg))
#define P_zm ((bf16_t*)(p.ws + O_zm))
#define P_ysg ((bf16_t*)(p.ws + O_ysg))
#define P_ysm ((bf16_t*)(p.ws + O_ysm))
#define P_mgd ((bf16_t*)(p.ws + O_mgd))
#define P_mgdm ((bf16_t*)(p.ws + O_mgdm))
#define P_ygg ((bf16_t*)(p.ws + O_ygg))
#define P_ygm ((bf16_t*)(p.ws + O_ygm))
#define P_kvA ((float*)(p.ws + O_kvA))
#define P_kvB ((float*)(p.ws + O_kvB))
#define P_kvAm ((float*)(p.ws + O_kvAm))
#define P_kvBm ((float*)(p.ws + O_kvBm))
#define P_decA ((float*)(p.ws + O_decA))
#define P_decB ((float*)(p.ws + O_decB))
#define P_hloc ((bf16_t*)(p.ws + O_hloc))
#define P_cumA ((bf16_t*)(p.ws + O_cumA))
#define P_hlocm ((bf16_t*)(p.ws + O_hlocm))
#define P_cumAm ((bf16_t*)(p.ws + O_cumAm))
#define P_cha ((float*)(p.ws + O_cha))
#define P_chh ((float*)(p.ws + O_chh))
#define P_cin ((float*)(p.ws + O_cin))
#define P_chhm ((float*)(p.ws + O_chhm))
#define P_qkA ((bf16_t*)(p.ws + O_qkA))
#define P_qkm ((bf16_t*)(p.ws + O_qkm))


typedef __bf16 bf16v2_t __attribute__((ext_vector_type(2)));
typedef float f32v2_t __attribute__((ext_vector_type(2)));
DI bf16_t f2bf(float x) { const __bf16 b = (__bf16)x; return __builtin_bit_cast(unsigned short, b); }
DI float bf2f(bf16_t b) { return __uint_as_float(((unsigned)b) << 16); }
DI unsigned pk2(float lo, float hi) { const f32v2_t v = {lo, hi}; const bf16v2_t b = __builtin_convertvector(v, bf16v2_t); return __builtin_bit_cast(unsigned, b); }
DI float sigmoidf_(float x) { return __builtin_amdgcn_rcpf(1.f + __expf(-x)); }
DI float siluf_(float x) { return x * __builtin_amdgcn_rcpf(1.f + __expf(-x)); }
DI float logsigmoidf_(float x) { return fminf(x, 0.f) - __logf(1.f + __expf(-fabsf(x))); }
DI float softplusf_(float x) { return fmaxf(x, 0.f) + __logf(1.f + __expf(-fabsf(x))); }
DI float geluf_(float x) { const float u = 0.7978845608028654f * (x + 0.044715f * x * x * x); return x * __builtin_amdgcn_rcpf(1.f + __expf(-2.f * u)); }
DI int opq(int x) { asm volatile("" : "+v"(x)); return x; }
DI int opqs(int x) { asm volatile("" : "+s"(x)); return x; }
DI int crow(int reg, int h) { return (reg & 3) + 8 * (reg >> 2) + 4 * h; }
DI f32x16 zero16() { f32x16 z; for (int i = 0; i < 16; ++i) z[i] = 0.f; return z; }
DI bf16x8 pack8(float a0, float a1, float a2, float a3, float a4, float a5, float a6, float a7) {
  u32x4 p; p[0] = pk2(a0, a1); p[1] = pk2(a2, a3); p[2] = pk2(a4, a5); p[3] = pk2(a6, a7);
  return __builtin_bit_cast(bf16x8, p);
}

#define XB_TMO      128
#define XB_XCNT(j)  (256  + 64 * (j))
#define XB_XSUB(j)  (1280 + 64 * (j))
#define XB_XGEN(j)  (2304 + 64 * (j))
#define XB_TOP      3328
#define XB_TOPGEN   3392
#define XB_SPIN_CAP (1u << 22)
DI unsigned xb_ld(unsigned* p) { return __hip_atomic_load(p, __ATOMIC_RELAXED, __HIP_MEMORY_SCOPE_AGENT); }
DI unsigned xb_add(unsigned* p, unsigned v) { return __hip_atomic_fetch_add(p, v, __ATOMIC_RELAXED, __HIP_MEMORY_SCOPE_AGENT); }
DI unsigned xb_xcc_id() { return (unsigned)__builtin_amdgcn_s_getreg((3 << 11) | 20) & 0xFu; }
#define XB_SPIN(cond, bar) do { unsigned _sp = 0; while (cond) { __builtin_amdgcn_s_sleep(1); \
    if ((++_sp & 255u) == 0u) { if (xb_ld(&(bar)[XB_TMO])) break; if (_sp > XB_SPIN_CAP) { atomicAdd(&(bar)[XB_TMO], 1u); break; } } } } while (0)
DI void xcd_barrier_complete(unsigned* bar, unsigned x, unsigned& nloc, unsigned& nx) {
  const unsigned G = gridDim.x;
  unsigned sum, cnt, mine, sp = 0u;
  for (;;) {
    sum = 0u; cnt = 0u; mine = 0u;
#pragma unroll
    for (unsigned j = 0; j < 16; ++j) { const unsigned c = xb_ld(&bar[XB_XCNT(j)]); sum += c; cnt += (c > 0u) ? 1u : 0u; mine = (j == x) ? c : mine; }
    if (sum == G) break;
    __builtin_amdgcn_s_sleep(1);
    if ((++sp & 255u) == 0u) { if (xb_ld(&bar[XB_TMO])) break; if (sp > XB_SPIN_CAP) { atomicAdd(&bar[XB_TMO], 1u); break; } }
  }
  nloc = mine > 0u ? mine : 1u; nx = cnt > 0u ? cnt : 1u;
}
DI void gbar(unsigned* ctrl, unsigned& xcc) {
  unsigned* bar = ctrl + 1024;
  volatile __attribute__((address_space(3))) unsigned* st = (volatile __attribute__((address_space(3))) unsigned*)(unsigned)(LDS_BYTES - 32);
  asm volatile("s_waitcnt vmcnt(0)" ::: "memory");
  __syncthreads();
  if (threadIdx.x == 0) {
    __builtin_amdgcn_s_waitcnt(0);
    unsigned nloc = st[0], nx = st[1];
    if (nloc == 0u) { xcd_barrier_complete(bar, xcc, nloc, nx); st[0] = nloc; st[1] = nx; }
    const unsigned old = xb_add(&bar[XB_XSUB(xcc)], 1u);
    const unsigned gen = old / nloc;
    if (old + 1u == (gen + 1u) * nloc) {
      __builtin_amdgcn_fence(__ATOMIC_RELEASE, "agent");
      asm volatile("s_waitcnt vmcnt(0)" ::: "memory");
      const unsigned og = xb_add(&bar[XB_TOP], 1u);
      const unsigned tg = og / nx;
      if (og + 1u == (tg + 1u) * nx) xb_add(&bar[XB_TOPGEN], 1u);
      else XB_SPIN(xb_ld(&bar[XB_TOPGEN]) == tg, bar);
      __builtin_amdgcn_fence(__ATOMIC_ACQUIRE, "agent");
      xb_add(&bar[XB_XGEN(xcc)], 1u);
      asm volatile("s_waitcnt vmcnt(0)" ::: "memory");
    } else {
      XB_SPIN(xb_ld(&bar[XB_XGEN(xcc)]) == gen, bar);
      __builtin_amdgcn_fence(__ATOMIC_ACQUIRE, "agent");
      asm volatile("s_waitcnt vmcnt(0)" ::: "memory");
    }
  }
  __syncthreads();
}

DI int swz(int r, int c) { return r * 128 + ((c ^ ((r >> 1) & 7)) << 4); }

DI void gemm_main(const bf16_t* __restrict__ A, int lda, const bf16_t* __restrict__ Bt, int ldb, int K, char* lds, f32x16 (&acc)[2][2], int small = 0,
                  const bf16_t* __restrict__ gate = nullptr, int gate_ld = 0) {
  const int tid = opq((int)threadIdx.x), lane = tid & 63, w = tid >> 6, r = lane & 31, h = lane >> 5;
  const int wm = w & 3, wn = w >> 2;
  const int lrow = tid >> 3, lc = (tid & 7) ^ ((tid >> 4) & 7);
  const bf16_t* ga = A + (size_t)lrow * lda + lc * 8;
  const bf16_t* gb = Bt + (size_t)lrow * ldb + lc * 8;
  const int nk = K >> 6;
  typedef __attribute__((address_space(3))) unsigned lds_u32;
#define G_STAGE(S, KT) do { char* sb_ = lds + (S) * 49152 + tid * 16; \
    _Pragma("unroll") for (int u = 0; u < 4; ++u) __builtin_amdgcn_global_load_lds((const unsigned*)(ga + (size_t)(64 * u) * lda + (KT) * 64), (lds_u32*)(sb_ + u * 8192), 16, 0, 0); \
    _Pragma("unroll") for (int u = 0; u < 2; ++u) __builtin_amdgcn_global_load_lds((const unsigned*)(gb + (size_t)(64 * u) * ldb + (KT) * 64), (lds_u32*)(sb_ + 32768 + u * 8192), 16, 0, 0); } while (0)
#define G_COMPUTE(S) do { const char* la_ = lds + (S) * 49152; const char* lb_ = la_ + 32768; \
    if (!small) { \
    _Pragma("unroll") for (int ks = 0; ks < 4; ++ks) { \
      bf16x8 xf[2], wf[2]; \
      _Pragma("unroll") for (int j = 0; j < 2; ++j) xf[j] = *(const bf16x8*)(la_ + swz(wm * 64 + j * 32 + r, ks * 2 + h)); \
      _Pragma("unroll") for (int i = 0; i < 2; ++i) wf[i] = *(const bf16x8*)(lb_ + swz(wn * 64 + i * 32 + r, ks * 2 + h)); \
      _Pragma("unroll") for (int i = 0; i < 2; ++i) _Pragma("unroll") for (int j = 0; j < 2; ++j) acc[i][j] = MFMA32(wf[i], xf[j], acc[i][j]); } \
    } else if (wm == 0) { \
    _Pragma("unroll") for (int ks = 0; ks < 4; ++ks) { \
      const bf16x8 xf0 = *(const bf16x8*)(la_ + swz(r, ks * 2 + h)); \
      _Pragma("unroll") for (int i = 0; i < 2; ++i) { const bf16x8 wfi = *(const bf16x8*)(lb_ + swz(wn * 64 + i * 32 + r, ks * 2 + h)); acc[i][0] = MFMA32(wfi, xf0, acc[i][0]); } } \
    } } while (0)
  asm volatile("s_waitcnt vmcnt(0) lgkmcnt(0)" ::: "memory");
  __builtin_amdgcn_s_barrier();
  G_STAGE(0, 0);
  G_STAGE(1, 1);
  int s0 = 0, s1 = 1, s2 = 2;
#pragma unroll 1
  for (int kt = 0; kt < nk; ++kt) {
    if (kt + 1 < nk) asm volatile("s_waitcnt vmcnt(6)" ::: "memory");
    else asm volatile("s_waitcnt vmcnt(0)" ::: "memory");
    __builtin_amdgcn_s_barrier();
    if (kt + 2 < nk) G_STAGE(s2, kt + 2);
    else if (gate) {
      const bf16_t* gsrc = gate + (size_t)(tid >> 4) * gate_ld + (((tid & 15) ^ ((tid >> 4) & 15)) << 3);
      char* gdst = lds + s2 * 49152 + tid * 16;
      if (kt + 2 == nk) {
#pragma unroll
        for (int u = 0; u < 6; ++u) __builtin_amdgcn_global_load_lds((const unsigned*)(gsrc + (size_t)(u * 32) * gate_ld), (lds_u32*)(gdst + u * 8192), 16, 0, 2);
      } else {
#pragma unroll
        for (int u = 0; u < 2; ++u) __builtin_amdgcn_global_load_lds((const unsigned*)(gsrc + (size_t)(192 + u * 32) * gate_ld), (lds_u32*)(gdst + u * 8192), 16, 0, 2);
      }
    }
    G_COMPUTE(s0);
    const int t = s0; s0 = s1; s1 = s2; s2 = t;
  }
  asm volatile("s_waitcnt vmcnt(0) lgkmcnt(0)" ::: "memory");
  __builtin_amdgcn_s_barrier();
#undef G_STAGE
#undef G_COMPUTE
}

DI int swz32(int r, int c) { return r * 64 + ((c ^ ((r >> 2) & 3)) << 4); }
DI void gemm_main_256(const bf16_t* __restrict__ A, int lda, const bf16_t* __restrict__ Bt, int ldb, int K, char* lds, f32x16 (&acc)[2][4]) {
  const int tid = opq((int)threadIdx.x), lane = tid & 63, w = tid >> 6, r = lane & 31, h = lane >> 5;
  const int wm = w & 1, wn = w >> 1;
  const int lrow = tid >> 2, lc = (tid & 3) ^ ((tid >> 4) & 3);
  const bf16_t* ga = A + (size_t)lrow * lda + lc * 8;
  const bf16_t* gb = Bt + (size_t)lrow * ldb + lc * 8;
  const int nk = K >> 5;
  typedef __attribute__((address_space(3))) unsigned lds_u32;
#define H_STAGE(S, KT) do { char* sb_ = lds + (S) * 32768 + tid * 16; \
    _Pragma("unroll") for (int u = 0; u < 2; ++u) __builtin_amdgcn_global_load_lds((const unsigned*)(ga + (size_t)(128 * u) * lda + (KT) * 32), (lds_u32*)(sb_ + u * 8192), 16, 0, 0); \
    _Pragma("unroll") for (int u = 0; u < 2; ++u) __builtin_amdgcn_global_load_lds((const unsigned*)(gb + (size_t)(128 * u) * ldb + (KT) * 32), (lds_u32*)(sb_ + 16384 + u * 8192), 16, 0, 0); } while (0)
#define H_COMPUTE(S) do { const char* la_ = lds + (S) * 32768; const char* lb_ = la_ + 16384; \
    _Pragma("unroll") for (int ks = 0; ks < 2; ++ks) { \
      bf16x8 xf[4], wf[2]; \
      _Pragma("unroll") for (int i = 0; i < 2; ++i) wf[i] = *(const bf16x8*)(lb_ + swz32(wn * 64 + i * 32 + r, ks * 2 + h)); \
      _Pragma("unroll") for (int j = 0; j < 4; ++j) xf[j] = *(const bf16x8*)(la_ + swz32(wm * 128 + j * 32 + r, ks * 2 + h)); \
      _Pragma("unroll") for (int j = 0; j < 4; ++j) _Pragma("unroll") for (int i = 0; i < 2; ++i) acc[i][j] = MFMA32(wf[i], xf[j], acc[i][j]); } } while (0)
  asm volatile("s_waitcnt vmcnt(0) lgkmcnt(0)" ::: "memory");
  __builtin_amdgcn_s_barrier();
  H_STAGE(0, 0);
  H_STAGE(1, 1);
  H_STAGE(2, 2);
#pragma unroll 1
  for (int kt = 0; kt < nk; ++kt) {
    const int rem = nk - 1 - kt;
    if (rem >= 2) asm volatile("s_waitcnt vmcnt(8)" ::: "memory");
    else if (rem == 1) asm volatile("s_waitcnt vmcnt(4)" ::: "memory");
    else asm volatile("s_waitcnt vmcnt(0)" ::: "memory");
    __builtin_amdgcn_s_barrier();
    if (kt + 3 < nk) H_STAGE((kt + 3) & 3, kt + 3);
    H_COMPUTE(kt & 3);
  }
  asm volatile("s_waitcnt lgkmcnt(0)" ::: "memory");
  __builtin_amdgcn_s_barrier();
#undef H_STAGE
#undef H_COMPUTE
}

DI int win_origcol(int n) { return n < 1024 ? n : (n < 5632 ? n + 16 : (n < 5648 ? n - 5632 + 1024 : (n < 5760 ? -1 : n - 112))); }

DI void transpose_tile(const float* __restrict__ src, int src_ld, int k0, int n0, bool winmap, const float* __restrict__ scale,
                       bf16_t* __restrict__ dst, int dst_ld, float* t) {
  const int tid = opq((int)threadIdx.x);
  const int nn = tid & 63, kb = tid >> 6;
  int col = n0 + nn; if (winmap) col = win_origcol(col);
#pragma unroll
  for (int it = 0; it < 8; ++it) {
    const int kk = kb + 8 * it;
    float v = 0.f;
    if (col >= 0) { v = __builtin_nontemporal_load(src + (size_t)(k0 + kk) * src_ld + col); if (scale) v *= scale[k0 + kk]; }
    t[kk * 65 + nn] = v;
  }
  __syncthreads();
  const int n2 = tid >> 3, kc = tid & 7;
  u32x4 o;
#pragma unroll
  for (int e = 0; e < 4; ++e) o[e] = pk2(t[(kc * 8 + 2 * e) * 65 + n2], t[(kc * 8 + 2 * e + 1) * 65 + n2]);
  *(u32x4*)(dst + (size_t)(n0 + n2) * dst_ld + k0 + kc * 8) = o;
  __syncthreads();
}

DI void s5_precompute(const Params& p, int l, int g, char* smem) {
  float* Apr = (float*)smem;
  float* Api = Apr + 33 * 64;
  float* Cre = Api + 33 * 64;
  float* Cim = Cre + 1024;
  float* Bre = Cim + 1024;
  float* Bim = Bre + 1024;
  float* Kt = Bim + 1024;
  const int tid = opq((int)threadIdx.x);
  const int lg = l * 32 + g;
  if (tid < 64) {
    const int n = tid;
    const float lr = p.lam_re[lg * 64 + n], li = p.lam_im[lg * 64 + n], dt = expf(p.log_dt[lg]);
    const float mag = expf(lr * dt), are = mag * cosf(li * dt), aim = mag * sinf(li * dt);
    const float nr = are - 1.f, ni = aim, den = lr * lr + li * li;
    const float cr = (nr * lr + ni * li) / den, ci = (ni * lr - nr * li) / den;
    for (int c = 0; c < 16; ++c) {
      const float br = p.b_re[(lg * 64 + n) * 16 + c], bi = p.b_im[(lg * 64 + n) * 16 + c];
      Bre[n * 16 + c] = cr * br - ci * bi; Bim[n * 16 + c] = cr * bi + ci * br;
    }
  }
  for (int idx = tid; idx < 33 * 64; idx += NTHR) {
    const int m = idx >> 6, n = idx & 63;
    const float lr = p.lam_re[lg * 64 + n], li = p.lam_im[lg * 64 + n], dt = expf(p.log_dt[lg]);
    const float mg = expf(lr * dt * (float)m), ang = li * dt * (float)m;
    Apr[idx] = mg * cosf(ang); Api[idx] = mg * sinf(ang);
    if (m == 32) { P_AL[(lg * 64 + n) * 2 + 0] = Apr[idx]; P_AL[(lg * 64 + n) * 2 + 1] = Api[idx]; }
  }
  for (int idx = tid; idx < 1024; idx += NTHR) { Cre[idx] = p.c_re[lg * 1024 + idx]; Cim[idx] = p.c_im[lg * 1024 + idx]; }
  __syncthreads();
  for (int e = tid; e < 8192; e += NTHR) {
    const int m = e >> 8, c = (e >> 4) & 15, c2 = e & 15;
    float s = 0.f;
    for (int n = 0; n < 64; ++n) {
      const float ar = Apr[m * 64 + n], ai = Api[m * 64 + n], br = Bre[n * 16 + c2], bi = Bim[n * 16 + c2];
      const float wr = ar * br - ai * bi, wi = ar * bi + ai * br;
      s += Cre[c * 64 + n] * wr - Cim[c * 64 + n] * wi;
    }
    Kt[e] = s;
  }
  __syncthreads();
  bf16_t* TMg = P_TM + (size_t)lg * 512 * 640;
  {
    const int s = tid >> 4, c2 = tid & 15;
    for (int row = 0; row < 512; ++row) {
      const int j = row >> 4, c = row & 15;
      const float v = (s <= j) ? Kt[((j - s) << 8) + (c << 4) + c2] : 0.f;
      TMg[row * 640 + tid] = f2bf(v);
    }
  }
  for (int idx = tid; idx < 512 * 128; idx += NTHR) {
    const int row = idx >> 7, kk = idx & 127, j = row >> 4, c = row & 15, n = kk & 63, im = kk >> 6;
    const float ar = Apr[(j + 1) * 64 + n], ai = Api[(j + 1) * 64 + n], cr = Cre[c * 64 + n], ci = Cim[c * 64 + n];
    TMg[row * 640 + 512 + kk] = f2bf(im ? -(cr * ai + ci * ar) : (cr * ar - ci * ai));
  }
  bf16_t* Pg = P_PS + (size_t)lg * 128 * 512;
  for (int e = tid; e < 128 * 512; e += NTHR) {
    const int row = e >> 9, k = e & 511, n = row & 63, s = k >> 4, c2 = k & 15, m = 31 - s;
    const float ar = Apr[m * 64 + n], ai = Api[m * 64 + n], br = Bre[n * 16 + c2], bi = Bim[n * 16 + c2];
    Pg[e] = f2bf(row < 64 ? (ar * br - ai * bi) : (ar * bi + ai * br));
  }
  __syncthreads();
}

DI void prologue(const Params& p, char* smem) {
  const int tid = opq((int)threadIdx.x), bid = blockIdx.x, nb = gridDim.x;
  constexpr int T_WIN = 16 * 154;
  constexpr int T_WB = 8 * 16;
  constexpr int T_WO = 16 * 16;
  constexpr int T_GL = 8 * 8;
  constexpr int NT_ALL = 2 * T_WIN + 8 * T_WB + 2 * T_WO + 2 * T_GL + 32;
  float* tbuf = (float*)smem;
  constexpr int NT_HEAD = 192 * 20;
  const bool s5wg = (bid < 64) && (nb > 64);
  if (s5wg) s5_precompute(p, bid >> 5, bid & 31, smem);
  for (int it = (s5wg ? NT_HEAD + bid : (nb > 64 ? bid - 64 : bid)); it < NT_ALL; ) {
    int t = it;
    if (nb > 64) it += (it < NT_HEAD) ? (nb - 64) : nb; else it += nb;
    if (nb > 64 && t < NT_HEAD && it >= NT_HEAD) it = NT_HEAD + bid;
    if (t < 2 * T_WIN) {
      const int l = t / T_WIN, tt = t % T_WIN, kt = tt / 154, nt = tt % 154;
      transpose_tile(p.w_in + (size_t)l * DM * INW, INW, kt * 64, nt * 64, true, p.ng + l * DM, P_WinT + (size_t)l * ZW * DM, DM, tbuf);
      continue;
    }
    t -= 2 * T_WIN;
    if (t < 8 * T_WB) {
      const int lb = t / T_WB, tt = t % T_WB, kt = tt / 16, nt = tt % 16;
      transpose_tile(p.w_br + (size_t)lb * 512 * DM, DM, kt * 64, nt * 64, false, nullptr, P_WbT + (size_t)lb * DM * 512, 512, tbuf);
      continue;
    }
    t -= 8 * T_WB;
    if (t < 2 * T_WO) {
      const int l = t / T_WO, tt = t % T_WO, kt = tt / 16, nt = tt % 16;
      transpose_tile(p.w_out + (size_t)l * DM * DM, DM, kt * 64, nt * 64, false, nullptr, P_WoutT + (size_t)l * DM * DM, DM, tbuf);
      continue;
    }
    t -= 2 * T_WO;
    if (t < 2 * T_GL) {
      const int l = t / T_GL, tt = t % T_GL, kt = tt / 8, nt = tt % 8;
      transpose_tile(p.gluw + (size_t)l * 512 * 512, 512, kt * 64, nt * 64, false, nullptr, P_gluT + (size_t)l * 512 * 512, 512, tbuf);
      continue;
    }
    t -= 2 * T_GL;
    {
      const int which = t >> 4, lk = t & 15;
      transpose_tile((which ? p.wx : p.wa) + (size_t)lk * 4096, 64, 0, 0, false, nullptr, (which ? P_wxT : P_waT) + (size_t)lk * 4096, 64, tbuf);
    }
  }
  {
    const int lane = tid & 63, gw = bid * 8 + (tid >> 6), ngw = nb * 8;
    for (int row = gw; row < NROWS; row += ngw) {
      const float* src = nullptr;
      if (row < MROW0) src = p.x + (size_t)row * DM;
      else { const int j = row - MROW0; if (j >= 16 && j < 32) src = p.meta + (size_t)(j - 16) * DM; }
      float s = 0.f;
#pragma unroll
      for (int q = 0; q < 4; ++q) {
        f32x4 v = {0.f, 0.f, 0.f, 0.f};
        if (src) v = __builtin_nontemporal_load((const f32x4*)(src + q * 256 + lane * 4));
        s += v[0] * v[0] + v[1] * v[1] + v[2] * v[2] + v[3] * v[3];
        u32x2 o; o[0] = pk2(v[0], v[1]); o[1] = pk2(v[2], v[3]);
        *(u32x2*)(P_hb + (size_t)row * DM + q * 256 + lane * 4) = o;
        if (row >= MROW0) *(f32x4*)(P_hmeta + (size_t)(row - MROW0) * DM + q * 256 + lane * 4) = v;
      }
#pragma unroll
      for (int o = 1; o < 64; o <<= 1) s += __shfl_xor(s, o);
      if (lane == 0) { P_ss[row] = s; P_ss[NROWS + row] = 0.f; P_ss[2 * NROWS + row] = 0.f; }
    }
  }
  if (nb <= 64) for (int it = bid; it < 64; it += nb) s5_precompute(p, it >> 5, it & 31, smem);
}

struct UnitD {
  const bf16_t* z; const bf16_t* halo; bf16_t* ys;
  bf16_t *kvA, *kvB; const bf16_t *sA, *sB; float *decA, *decB;
  bf16_t *hloc, *cumA; float *cha, *chh; const float* cin;
  int pad, meta, uu;
};
DI UnitD make_unit(const Params& p, int uu) {
  UnitD u;
  if (uu < NUNIT) {
    const int bl = uu / NCH, c = uu % NCH; const size_t rb = (size_t)bl * SEQ + c * 32;
    u.z = P_zg + rb * ZW; u.halo = c > 0 ? (u.z - 3 * ZW) : (P_zm + 29 * ZW); u.ys = P_ysg + rb * 2048;
    u.kvA = (bf16_t*)P_kvA + (size_t)uu * 32768; u.kvB = (bf16_t*)P_kvB + (size_t)uu * 65536;
    u.sA = (const bf16_t*)P_kvA + (size_t)(NUNIT + uu) * 32768; u.sB = (const bf16_t*)P_kvB + (size_t)(NUNIT + uu) * 65536; u.decA = P_decA + uu * 256; u.decB = P_decB + uu * 512;
    u.hloc = P_hloc + rb * 512; u.cumA = P_cumA + rb * 512; u.cha = P_cha + uu * 512; u.chh = P_chh + uu * 512; u.cin = P_cin + uu * 512;
    u.pad = 0; u.meta = 0; u.uu = uu;
  } else {
    u.z = P_zm; u.halo = nullptr; u.ys = P_ysm; u.kvA = (bf16_t*)P_kvAm; u.kvB = (bf16_t*)P_kvBm; u.sA = nullptr; u.sB = nullptr; u.decA = nullptr; u.decB = nullptr;
    u.hloc = P_hlocm; u.cumA = P_cumAm; u.cha = nullptr; u.chh = P_chhm; u.cin = nullptr; u.pad = 16; u.meta = 1; u.uu = 0;
  }
  return u;
}

template <bool IS_GLA>
DI void gcum_build(const Params& p, const UnitD& u, int l, int half, float* Gs, float* lrs) {
  const int tid = opq((int)threadIdx.x);
  const int d = tid & 255, jh = tid >> 8;
  if (IS_GLA) {
    { const int j = tid >> 4, i = tid & 15; lrs[tid] = bf2f(u.z[(size_t)j * ZW + ZC_LR + i]); }
    __syncthreads();
    float wv[16];
#pragma unroll
    for (int i = 0; i < 16; ++i) wv[i] = p.w_lr[(l * 16 + i) * 256 + d];
    const float b = p.b_lr[l * 256 + d];
#pragma unroll 4
    for (int jj = 0; jj < 16; ++jj) {
      const int j = jh * 16 + jj;
      float a = b;
#pragma unroll
      for (int i = 0; i < 16; ++i) a += lrs[j * 16 + i] * wv[i];
      Gs[j * 256 + d] = (j < u.pad) ? 0.f : logsigmoidf_(a) * (1.f / 16.f);
    }
  } else {
    const int dg = half * 256 + d;
    const float lb = (l == 0) ? 0.f : sigmoidf_(p.lbl[512 + dg] - p.lbl[dg]);
    bf16_t raw[16];
#pragma unroll
    for (int jj = 0; jj < 16; ++jj) raw[jj] = u.z[(size_t)(jh * 16 + jj) * ZW + ZC_HF + dg];
#pragma unroll
    for (int jj = 0; jj < 16; ++jj) {
      const int j = jh * 16 + jj;
      const float f = lb + (1.f - lb) * sigmoidf_(bf2f(raw[jj]));
      Gs[j * 256 + d] = (j < u.pad) ? 0.f : __logf(f);
    }
  }
  __syncthreads();
  {
    const int dd = tid & 255, sg = tid >> 8;
    float v[16], base = 0.f;
    if (sg == 1) {
#pragma unroll
      for (int j = 0; j < 16; ++j) base += Gs[j * 256 + dd];
    }
#pragma unroll
    for (int j = 0; j < 16; ++j) v[j] = Gs[(sg * 16 + j) * 256 + dd];
    __syncthreads();
    float run = base;
#pragma unroll
    for (int j = 0; j < 16; ++j) { run += v[j]; Gs[(sg * 16 + j) * 256 + dd] = run; }
  }
  __syncthreads();
}

template <bool IS_GLA>
DI float kval_raw(bf16_t raw, float lb) {
  if (IS_GLA) return bf2f(raw);
  return 1.f - (lb + (1.f - lb) * sigmoidf_(bf2f(raw)));
}
template <bool IS_GLA>
DI float kval_of(const Params& p, const UnitD& u, int l, int half, int j, int d) {
  if (IS_GLA) return bf2f(u.z[(size_t)j * ZW + ZC_GK + d]);
  const int dg = half * 256 + d;
  const float lb = (l == 0) ? 0.f : sigmoidf_(p.lbl[512 + dg] - p.lbl[dg]);
  const float xv = bf2f(u.z[(size_t)j * ZW + ZC_HF + dg]);
  return 1.f - (lb + (1.f - lb) * sigmoidf_(xv));
}

template <bool IS_GLA>
DI bf16_t* qk_block(const Params& p, const UnitD& u, int half) {
  if (u.meta) return P_qkm + (IS_GLA ? 0 : (1 + half)) * 16384;
  if (IS_GLA) return P_qkA + (size_t)u.uu * 16384;
  return P_mgd + ((size_t)u.uu * 2 + half) * 16384;
}

template <bool IS_GLA>
DI void gla_local(const Params& p, const UnitD& u, int l, int half, char* smem) {
  constexpr int NH = IS_GLA ? 4 : 2, DK = IS_GLA ? 64 : 128, NV = NH * 128, DKT = DK / 32;
  float* Gs = (float*)smem; float* lrs = (float*)(smem + 32768);
  bf16_t* kT = (bf16_t*)(smem + 34816); bf16_t* vT = (bf16_t*)(smem + 55296);
  const int tid = opq((int)threadIdx.x), lane = tid & 63, w = tid >> 6, r = lane & 31, h = lane >> 5;
  gcum_build<IS_GLA>(p, u, l, half, Gs, lrs);
  if (!u.meta && tid < 256) {
    const float dv = __expf(Gs[31 * 256 + tid]);
    if (IS_GLA) u.decA[tid] = dv; else u.decB[half * 256 + tid] = dv;
  }
  {
    const int d = tid & 255, jb = tid >> 8;
    const int kcol = IS_GLA ? (ZC_GK + d) : (ZC_HF + half * 256 + d);
    float lb = 0.f;
    if (!IS_GLA && l != 0) lb = sigmoidf_(p.lbl[512 + half * 256 + d] - p.lbl[half * 256 + d]);
    const int qcol = IS_GLA ? (ZC_GQ + d) : (ZC_HQ + half * 256 + d);
    const float qscale = IS_GLA ? 0.125f : 1.f;
    bf16_t raw[16], rawq[16];
#pragma unroll
    for (int it = 0; it < 16; ++it) { raw[it] = u.z[(size_t)(jb * 16 + it) * ZW + kcol]; rawq[it] = u.z[(size_t)(jb * 16 + it) * ZW + qcol]; }
    const float gl = Gs[31 * 256 + d];
    bf16_t* QL = (bf16_t*)(smem + 96256); bf16_t* KL = (bf16_t*)(smem + 113152);
    float kend[16];
#pragma unroll
    for (int it = 0; it < 16; ++it) {
      const int j = jb * 16 + it;
      float kv = 0.f, qv = 0.f, kiv = 0.f;
      if (j >= u.pad) {
        const float g = Gs[j * 256 + d], kk = kval_raw<IS_GLA>(raw[it], lb);
        kv = kk * __expf(gl - g);
        qv = bf2f(rawq[it]) * qscale * __expf(g);
        kiv = kk * __expf(-g);
      }
      kend[it] = kv;
      QL[j * 264 + d] = f2bf(qv); KL[j * 264 + d] = f2bf(kiv);
    }
    u32x4 k0, k1;
#pragma unroll
    for (int e = 0; e < 4; ++e) { k0[e] = pk2(kend[2 * e], kend[2 * e + 1]); k1[e] = pk2(kend[8 + 2 * e], kend[8 + 2 * e + 1]); }
    *(u32x4*)(kT + d * 40 + jb * 16) = k0; *(u32x4*)(kT + d * 40 + jb * 16 + 8) = k1;
  }
  const int vcol = IS_GLA ? ZC_GV : (ZC_HI + half * 256);
  {
    constexpr int NBATCH = NV / 256;
    const int v = tid % NV, jbase = (tid / NV) * 16;
#pragma unroll 1
    for (int bb = 0; bb < NBATCH; ++bb) {
      const int j0 = jbase + bb * 16;
      bf16_t raw[16];
#pragma unroll
      for (int i = 0; i < 16; ++i) raw[i] = u.z[(size_t)(j0 + i) * ZW + vcol + v];
      u32x4 w0, w1;
#pragma unroll
      for (int e = 0; e < 4; ++e) {
        const unsigned a0 = (j0 + 2 * e >= u.pad) ? raw[2 * e] : 0u, a1 = (j0 + 2 * e + 1 >= u.pad) ? raw[2 * e + 1] : 0u;
        const unsigned b0 = (j0 + 8 + 2 * e >= u.pad) ? raw[8 + 2 * e] : 0u, b1 = (j0 + 8 + 2 * e + 1 >= u.pad) ? raw[8 + 2 * e + 1] : 0u;
        w0[e] = a0 | (a1 << 16); w1[e] = b0 | (b1 << 16);
      }
      *(u32x4*)(vT + v * 40 + j0) = w0; *(u32x4*)(vT + v * 40 + j0 + 8) = w1;
    }
  }
  __syncthreads();
  {
    bf16_t* qkb = qk_block<IS_GLA>(p, u, half);
    const bf16_t* QL = (const bf16_t*)(smem + 96256); const bf16_t* KL = (const bf16_t*)(smem + 113152);
#pragma unroll
    for (int uu2 = 0; uu2 < 2; ++uu2) {
      const int c = tid + NTHR * uu2, row = c >> 5, chk = c & 31;
      *(u32x4*)(qkb + c * 8) = *(const u32x4*)(QL + row * 264 + chk * 8);
      *(u32x4*)(qkb + 8192 + c * 8) = *(const u32x4*)(KL + row * 264 + chk * 8);
    }
  }
  bf16_t* kvbase = IS_GLA ? u.kvA : (u.kvB + (size_t)half * 2 * 128 * 128);
#pragma unroll 1
  for (int tu = 0; tu < 4; ++tu) {
    const int tt = w * 4 + tu;
    const int dkt = tt % DKT, vt = (tt / DKT) % 4, hd = tt / (4 * DKT);
    f32x16 acc = zero16();
#pragma unroll
    for (int ks = 0; ks < 2; ++ks) {
      const bf16x8 a = *(const bf16x8*)(vT + (hd * 128 + vt * 32 + r) * 40 + ks * 16 + 8 * h);
      const bf16x8 b = *(const bf16x8*)(kT + (hd * DK + dkt * 32 + r) * 40 + ks * 16 + 8 * h);
      acc = MFMA32(b, a, acc);
    }
    bf16_t* dst = kvbase + ((size_t)hd * 128 + vt * 32 + r) * DK + dkt * 32 + 4 * h;
#pragma unroll
    for (int q = 0; q < 4; ++q) {
      u32x2 o; o[0] = pk2(acc[4 * q], acc[4 * q + 1]); o[1] = pk2(acc[4 * q + 2], acc[4 * q + 3]);
      *(u32x2*)(dst + 8 * q) = o;
    }
  }
  __syncthreads();
}

template <bool IS_GLA>
DI void gla_out(const Params& p, const UnitD& u, int l, int half, char* smem) {
  constexpr int NH = IS_GLA ? 4 : 2, DK = IS_GLA ? 64 : 128, NV = NH * 128, WPH = 8 / NH, VTP = 4 / WPH, KS = DK / 16;
  float* Gs = (float*)smem; float* lrs = (float*)(smem + 32768);
  bf16_t* qd = (bf16_t*)(smem + 34816); bf16_t* ki = (bf16_t*)(smem + 51712); bf16_t* vT = (bf16_t*)(smem + 68608);
  float* part = (float*)(smem + 109568);
  const int tid = opq((int)threadIdx.x), lane = tid & 63, w = tid >> 6, r = lane & 31, h = lane >> 5;
  (void)Gs; (void)lrs;
  bf16_t* GT = (bf16_t*)(smem + 112640);
  {
    const int gcol0 = IS_GLA ? ZC_GG : (ZC_HG + half * 256);
    constexpr int CPR = NV / 8, NCK = 32 * CPR / NTHR;
    u32x4 gt[NCK];
#pragma unroll
    for (int uu2 = 0; uu2 < NCK; ++uu2) { const int c = tid + NTHR * uu2, row = c / CPR, chk = c % CPR; gt[uu2] = *(const u32x4*)(u.z + (size_t)row * ZW + gcol0 + chk * 8); }
#pragma unroll
    for (int uu2 = 0; uu2 < NCK; ++uu2) { const int c = tid + NTHR * uu2, row = c / CPR, chk = c % CPR; *(u32x4*)(GT + row * (NV + 8) + chk * 8) = gt[uu2]; }
  }
  {
    const bf16_t* qkb = qk_block<IS_GLA>(p, u, half);
    u32x4 t0[2], t1[2];
#pragma unroll
    for (int uu2 = 0; uu2 < 2; ++uu2) { const int q = tid + NTHR * uu2; t0[uu2] = *(const u32x4*)(qkb + q * 8); t1[uu2] = *(const u32x4*)(qkb + 8192 + q * 8); }
#pragma unroll
    for (int uu2 = 0; uu2 < 2; ++uu2) { const int q = tid + NTHR * uu2, row = q >> 5, ch = q & 31; *(u32x4*)(qd + row * 264 + ch * 8) = t0[uu2]; *(u32x4*)(ki + row * 264 + ch * 8) = t1[uu2]; }
  }
  const int vcol = IS_GLA ? ZC_GV : (ZC_HI + half * 256);
  {
    constexpr int NBATCH = NV / 256;
    const int v = tid % NV, jbase = (tid / NV) * 16;
#pragma unroll 1
    for (int bb = 0; bb < NBATCH; ++bb) {
      const int j0 = jbase + bb * 16;
      bf16_t raw[16];
#pragma unroll
      for (int i = 0; i < 16; ++i) raw[i] = u.z[(size_t)(j0 + i) * ZW + vcol + v];
      u32x4 w0, w1;
#pragma unroll
      for (int e = 0; e < 4; ++e) {
        const unsigned a0 = (j0 + 2 * e >= u.pad) ? raw[2 * e] : 0u, a1 = (j0 + 2 * e + 1 >= u.pad) ? raw[2 * e + 1] : 0u;
        const unsigned b0 = (j0 + 8 + 2 * e >= u.pad) ? raw[8 + 2 * e] : 0u, b1 = (j0 + 8 + 2 * e + 1 >= u.pad) ? raw[8 + 2 * e + 1] : 0u;
        w0[e] = a0 | (a1 << 16); w1[e] = b0 | (b1 << 16);
      }
      *(u32x4*)(vT + v * 40 + j0) = w0; *(u32x4*)(vT + v * 40 + j0 + 8) = w1;
    }
  }
  __syncthreads();
  const int hd = w / WPH, sub = w % WPH;
  const int hdg = IS_GLA ? hd : (half * 2 + hd);
  f32x16 X = zero16();
#pragma unroll
  for (int ks = 0; ks < KS; ++ks) {
    const bf16x8 a = *(const bf16x8*)(ki + r * 264 + hd * DK + ks * 16 + 8 * h);
    const bf16x8 b = *(const bf16x8*)(qd + r * 264 + hd * DK + ks * 16 + 8 * h);
    X = MFMA32(a, b, X);
  }
#pragma unroll
  for (int reg = 0; reg < 16; ++reg) if (crow(reg, h) > r) X[reg] = 0.f;
  bf16x8 xs[2];
  xs[0] = pack8(X[0], X[1], X[2], X[3], X[4], X[5], X[6], X[7]);
  xs[1] = pack8(X[8], X[9], X[10], X[11], X[12], X[13], X[14], X[15]);
  f32x16 o[VTP];
  const bf16_t* Sbase = (IS_GLA ? u.sA : u.sB) + (size_t)hdg * 128 * DK;
#pragma unroll
  for (int vt = 0; vt < VTP; ++vt) {
    const int vg = sub * VTP + vt;
    o[vt] = zero16();
#pragma unroll
    for (int st = 0; st < 2; ++st) {
      const bf16x4 lo = *(const bf16x4*)(vT + (hd * 128 + vg * 32 + r) * 40 + 16 * st + 4 * h);
      const bf16x4 hi = *(const bf16x4*)(vT + (hd * 128 + vg * 32 + r) * 40 + 16 * st + 8 + 4 * h);
      const bf16x8 pb = __builtin_shufflevector(lo, hi, 0, 1, 2, 3, 4, 5, 6, 7);
      o[vt] = MFMA32(xs[st], pb, o[vt]);
    }
    if (!u.meta) {
      const bf16_t* Sp = Sbase + (size_t)(vg * 32 + r) * DK + 8 * h;
      bf16x8 sb[KS];
#pragma unroll
      for (int ks = 0; ks < KS; ++ks) sb[ks] = *(const bf16x8*)(Sp + ks * 16);
#pragma unroll
      for (int ks = 0; ks < KS; ++ks) {
        const bf16x8 a = *(const bf16x8*)(qd + r * 264 + hd * DK + ks * 16 + 8 * h);
        o[vt] = MFMA32(a, sb[ks], o[vt]);
      }
    }
  }
#pragma unroll
  for (int reg = 0; reg < 16; ++reg) {
    float s = 0.f;
#pragma unroll
    for (int vt = 0; vt < VTP; ++vt) s += o[vt][reg] * o[vt][reg];
#pragma unroll
    for (int off = 1; off < 32; off <<= 1) s += __shfl_xor(s, off);
    if (r == 0) part[w * 32 + crow(reg, h)] = s;
  }
  __syncthreads();
  const float* gn = (IS_GLA ? p.gnorm : p.hnorm) + (l * 4 + hdg) * 128;
  const int yoff = IS_GLA ? 0 : (512 + half * 256);
#pragma unroll
  for (int reg = 0; reg < 16; ++reg) {
    const int c = crow(reg, h);
    float tot = 0.f;
#pragma unroll
    for (int ww = 0; ww < WPH; ++ww) tot += part[(hd * WPH + ww) * 32 + c];
    const float rsq = rsqrtf(tot * (1.f / 128.f) + EPS);
#pragma unroll
    for (int vt = 0; vt < VTP; ++vt) {
      const int v = (sub * VTP + vt) * 32 + r;
      bf16_t* gp = GT + c * (NV + 8) + hd * 128 + v;
      const float gate = bf2f(*gp);
      *gp = f2bf(o[vt][reg] * rsq * gn[v] * siluf_(gate));
    }
  }
  __syncthreads();
  {
    constexpr int CPR = NV / 8, NCK = 32 * CPR / NTHR;
#pragma unroll
    for (int uu2 = 0; uu2 < NCK; ++uu2) {
      const int c = tid + NTHR * uu2, row = c / CPR, chk = c % CPR;
      *(u32x4*)(u.ys + (size_t)row * 2048 + yoff + chk * 8) = *(const u32x4*)(GT + row * (NV + 8) + chk * 8);
    }
  }
  __syncthreads();
}

DI void lru_local(const Params& p, const UnitD& u, int l, char* smem) {
  float* XC = (float*)smem;
  bf16_t* XCb = (bf16_t*)(smem + 33280);
  float* LA = (float*)(smem + 50176);
  const int tid = opq((int)threadIdx.x), lane = tid & 63, w = tid >> 6, r = lane & 31, h = lane >> 5;
#pragma unroll 1
  for (int hf = 0; hf < 2; ++hf) {
    {
      const int n = tid & 255, jh = tid >> 8, ch = hf * 256 + n, j0 = jh * 16;
      const float w0 = p.convw[(l * 4 + 0) * 512 + ch], w1 = p.convw[(l * 4 + 1) * 512 + ch], w2 = p.convw[(l * 4 + 2) * 512 + ch],
                  w3 = p.convw[(l * 4 + 3) * 512 + ch], cb = p.convb[l * 512 + ch];
      bf16_t xr[19];
#pragma unroll
      for (int i = 0; i < 19; ++i) {
        if (i < 3 && j0 == 0) xr[i] = u.halo ? u.halo[(size_t)i * ZW + ZC_LX + ch] : (bf16_t)0;
        else xr[i] = u.z[(size_t)(j0 - 3 + i) * ZW + ZC_LX + ch];
      }
      float x3 = bf2f(xr[0]), x2 = bf2f(xr[1]), x1 = bf2f(xr[2]);
#pragma unroll
      for (int jj = 0; jj < 16; ++jj) {
        const int j = j0 + jj;
        const float x0 = bf2f(xr[3 + jj]);
        const float xc = cb + w0 * x0 + w1 * x1 + w2 * x2 + w3 * x3;
        XC[j * 260 + n] = xc; XCb[j * 264 + n] = f2bf(xc);
        x3 = x2; x2 = x1; x1 = x0;
      }
    }
    __syncthreads();
    {
      const int blk = w >> 1, nt = w & 1, blkg = hf * 4 + blk;
      const bf16_t* wa = P_waT + ((size_t)(l * 8 + blkg) * 64 + nt * 32 + r) * 64 + 8 * h;
      const bf16_t* wx = P_wxT + ((size_t)(l * 8 + blkg) * 64 + nt * 32 + r) * 64 + 8 * h;
      f32x16 aa = zero16(), ax = zero16();
#pragma unroll
      for (int ks = 0; ks < 4; ++ks) {
        const bf16x8 a1 = *(const bf16x8*)(wa + ks * 16), a2 = *(const bf16x8*)(wx + ks * 16);
        const bf16x8 b = *(const bf16x8*)(XCb + r * 264 + blk * 64 + ks * 16 + 8 * h);
        aa = MFMA32(a1, b, aa); ax = MFMA32(a2, b, ax);
      }
#pragma unroll
      for (int q = 0; q < 4; ++q) {
        const int nn = blk * 64 + nt * 32 + 8 * q + 4 * h, chg = hf * 256 + nn;
        f32x4 xc = *(const f32x4*)(XC + r * 260 + nn);
        f32x4 av, iv;
#pragma unroll
        for (int i = 0; i < 4; ++i) {
          const float rr = sigmoidf_(aa[4 * q + i] + p.ba[l * 512 + chg + i]);
          const float ig = sigmoidf_(ax[4 * q + i] + p.bx[l * 512 + chg + i]);
          const float la = -8.f * rr * softplusf_(-p.lam[l * 512 + chg + i]);
          float a = __expf(la), inp = __builtin_amdgcn_sqrtf(fmaxf(1.f - __expf(2.f * la), 0.f)) * ig * xc[i];
          if (r < u.pad) { a = 1.f; inp = 0.f; }
          av[i] = a; iv[i] = inp;
        }
        *(f32x4*)(LA + r * 260 + nn) = av; *(f32x4*)(XC + r * 260 + nn) = iv;
      }
    }
    __syncthreads();
    if (tid < 256) {
      const int n = tid, ch = hf * 256 + n;
      float hh = 0.f, A = 1.f;
      for (int j = 0; j < 32; ++j) {
        const float a = LA[j * 260 + n], xv = XC[j * 260 + n];
        hh = a * hh + xv; A *= a;
        u.hloc[(size_t)j * 512 + ch] = f2bf(hh); u.cumA[(size_t)j * 512 + ch] = f2bf(A);
      }
      if (u.cha) u.cha[ch] = A;
      u.chh[ch] = hh;
    }
    __syncthreads();
  }
}

DI void lru_out(const Params& p, const UnitD& u, char* smem) {
  const int tid = opq((int)threadIdx.x);
  u32x4 hv[4], av[4], gv[4];
#pragma unroll
  for (int it = 0; it < 4; ++it) {
    const int idx = tid + NTHR * it, j = idx >> 6, c8 = idx & 63;
    hv[it] = *(const u32x4*)(u.hloc + (size_t)j * 512 + c8 * 8);
    av[it] = *(const u32x4*)(u.cumA + (size_t)j * 512 + c8 * 8);
    gv[it] = *(const u32x4*)(u.z + (size_t)j * ZW + ZC_LG + c8 * 8);
  }
#pragma unroll
  for (int it = 0; it < 4; ++it) {
    const int idx = tid + NTHR * it, j = idx >> 6, c8 = idx & 63;
    float ci[8];
#pragma unroll
    for (int e = 0; e < 8; ++e) ci[e] = u.cin ? u.cin[c8 * 8 + e] : 0.f;
    u32x4 o;
#pragma unroll
    for (int e = 0; e < 4; ++e) {
      float r2[2];
#pragma unroll
      for (int k = 0; k < 2; ++k) {
        const float hh = bf2f((bf16_t)(hv[it][e] >> (16 * k))), aa = bf2f((bf16_t)(av[it][e] >> (16 * k))), gt = bf2f((bf16_t)(gv[it][e] >> (16 * k)));
        r2[k] = (hh + aa * ci[2 * e + k]) * siluf_(gt);
      }
      o[e] = pk2(r2[0], r2[1]);
    }
    *(u32x4*)(u.ys + (size_t)j * 2048 + 1536 + c8 * 8) = o;
  }
}

DI void s5_item(const Params& p, int l, int grp, int bl, int gs, char* smem) {
  bf16_t* Ub = (bf16_t*)smem;
  float* E = (float*)(smem + 41472);
  char* FT = smem + 110112;
  const int tid = opq((int)threadIdx.x), lane = tid & 63, w = tid >> 6, r = lane & 31, h = lane >> 5;
  const int lg = l * 32 + gs;
  const bf16_t* Pg = P_PS + (size_t)lg * 128 * 512;
  const bf16_t* TMg = P_TM + (size_t)lg * 512 * 640;
  const bool wmeta = (grp == 0 && bl == 0);
  auto load_U = [&](int ut) {
#pragma unroll
    for (int it = 0; it < 4; ++it) {
      const int idx = tid + NTHR * it, m = idx >> 6, rem = idx & 63, s = rem >> 1, hv = rem & 1, uu = ut * 32 + m;
      u32x4 val = {0u, 0u, 0u, 0u};
      if (uu <= NCH) {
        const bf16_t* zr = (uu == 0) ? P_zm : (P_zg + ((size_t)bl * SEQ + (uu - 1) * 32) * ZW);
        val = *(const u32x4*)(zr + (size_t)s * ZW + ZC_SU + gs * 16 + hv * 8);
      }
      *(u32x4*)(Ub + m * 648 + s * 16 + hv * 8) = val;
    }
  };
  for (int idx = tid; idx < 33 * 64; idx += NTHR) {
    const int di = idx >> 6, ln = idx & 63, d = di - 1, rt0 = (d + (d & 1)) >> 1, ks0 = d & 1;
    *(u32x4*)(FT + di * 1024 + ln * 16) = *(const u32x4*)(TMg + (size_t)(rt0 * 32 + (ln & 31)) * 640 + ks0 * 16 + 8 * (ln >> 5));
  }
#pragma unroll 1
  for (int ut = 0; ut < 5; ++ut) {
    load_U(ut);
    __syncthreads();
    const int nt = w & 3, kh = w >> 2;
    f32x16 acc = zero16();
#pragma unroll 8
    for (int kk = 0; kk < 16; ++kk) {
      const int ks = kh * 16 + kk;
      const bf16x8 a = *(const bf16x8*)(Pg + (size_t)(nt * 32 + r) * 512 + ks * 16 + 8 * h);
      const bf16x8 b = *(const bf16x8*)(Ub + r * 648 + ks * 16 + 8 * h);
      acc = MFMA32(a, b, acc);
    }
    float* er = E + (ut * 32 + r) * 132 + nt * 32 + 4 * h;
    const bool uok = (ut * 32 + r) < 130;
    if (kh == 1 && uok) {
#pragma unroll
      for (int q = 0; q < 4; ++q) { f32x4 v = {acc[4 * q], acc[4 * q + 1], acc[4 * q + 2], acc[4 * q + 3]}; *(f32x4*)(er + 8 * q) = v; }
    }
    __syncthreads();
    if (kh == 0 && uok) {
#pragma unroll
      for (int q = 0; q < 4; ++q) {
        f32x4 v = *(const f32x4*)(er + 8 * q);
        v[0] += acc[4 * q]; v[1] += acc[4 * q + 1]; v[2] += acc[4 * q + 2]; v[3] += acc[4 * q + 3];
        *(f32x4*)(er + 8 * q) = v;
      }
    }
    __syncthreads();
  }
  if (tid < 64) {
    const int n = tid;
    const float ar = P_AL[(lg * 64 + n) * 2], ai = P_AL[(lg * 64 + n) * 2 + 1];
    float hr = 0.f, hi = 0.f;
    for (int uu = 0; uu <= NCH; ++uu) {
      const float er = E[uu * 132 + n], ei = E[uu * 132 + 64 + n];
      E[uu * 132 + n] = hr; E[uu * 132 + 64 + n] = hi;
      const float nhr = ar * hr - ai * hi + er, nhi = ar * hi + ai * hr + ei;
      hr = nhr; hi = nhi;
    }
  }
  __syncthreads();
#pragma unroll 1
  for (int ut = 0; ut < 5; ++ut) {
    load_U(ut);
    for (int idx = tid; idx < 32 * 128; idx += NTHR) {
      const int m = idx >> 7, kk = idx & 127;
      Ub[m * 648 + 512 + kk] = ((ut * 32 + m) < 130) ? f2bf(E[(ut * 32 + m) * 132 + kk]) : (bf16_t)0;
    }
    __syncthreads();
    f32x16 acc0 = zero16(), acc1 = zero16();
    const bf16_t* a0p = TMg + (size_t)(w * 32 + r) * 640 + 8 * h;
    const bf16_t* a1p = TMg + (size_t)((15 - w) * 32 + r) * 640 + 8 * h;
    const bf16_t* bp = Ub + r * 648 + 8 * h;
    {
      const int n0 = 2 * w + 2;
      const char* f0 = FT + (2 * w + 1) * 1024 + lane * 16;
#pragma unroll 2
      for (int ks = 0; ks < n0; ++ks) acc0 = MFMA32(*(const bf16x8*)(f0 - ks * 1024), *(const bf16x8*)(bp + ks * 16), acc0);
      const int n1 = 32 - 2 * w;
      const char* f1 = FT + (2 * (15 - w) + 1) * 1024 + lane * 16;
#pragma unroll 2
      for (int ks = 0; ks < n1; ++ks) acc1 = MFMA32(*(const bf16x8*)(f1 - ks * 1024), *(const bf16x8*)(bp + ks * 16), acc1);
#pragma unroll
      for (int ks = 32; ks < 40; ++ks) {
        const bf16x8 b = *(const bf16x8*)(bp + ks * 16);
        acc0 = MFMA32(*(const bf16x8*)(a0p + ks * 16), b, acc0); acc1 = MFMA32(*(const bf16x8*)(a1p + ks * 16), b, acc1);
      }
    }
    const int uu = ut * 32 + r;
    if (uu <= NCH && (uu > 0 || wmeta)) {
      bf16_t* yrow = (uu == 0) ? P_ygm : (P_ygg + ((size_t)bl * SEQ + (uu - 1) * 32) * 512);
#pragma unroll
      for (int rr = 0; rr < 2; ++rr) {
        const int rt = rr ? (15 - w) : w;
#pragma unroll
        for (int q = 0; q < 4; ++q) {
          const int j = rt * 2 + (q >> 1), c = 8 * (q & 1) + 4 * h, ch = gs * 16 + c;
          float yv[4];
#pragma unroll
          for (int i = 0; i < 4; ++i) {
            const float av = rr ? acc1[4 * q + i] : acc0[4 * q + i];
            const float uv = bf2f(Ub[r * 648 + j * 16 + c + i]);
            yv[i] = geluf_(av + p.s5d[l * 512 + ch + i] * uv);
          }
          u32x2 o; o[0] = pk2(yv[0], yv[1]); o[1] = pk2(yv[2], yv[3]);
          *(u32x2*)(yrow + (size_t)j * 512 + ch) = o;
        }
      }
    }
    __syncthreads();
  }
}

DI void gemm1_small_tile(const Params& p, int l, const bf16_t* A, bf16_t* out, const float* ss, int nt, char* smem) {
  const int tid = opq((int)threadIdx.x), lane = tid & 63, w = tid >> 6, r = lane & 31, h = lane >> 5, wm = w & 3, wn = w >> 2;
  f32x16 acc[2][2];
#pragma unroll
  for (int i = 0; i < 2; ++i) for (int j = 0; j < 2; ++j) acc[i][j] = zero16();
  gemm_main(A, DM, P_WinT + ((size_t)l * ZW + nt * 128) * DM, DM, DM, smem, acc);
#pragma unroll
  for (int j = 0; j < 2; ++j) {
    const int m = wm * 64 + j * 32 + r;
    const float rs = rsqrtf(ss[m] * (1.f / DM) + EPS);
#pragma unroll
    for (int i = 0; i < 2; ++i)
#pragma unroll
      for (int q = 0; q < 4; ++q) {
        const int n = nt * 128 + wn * 64 + i * 32 + 8 * q + 4 * h;
        u32x2 o; o[0] = pk2(acc[i][j][4 * q] * rs, acc[i][j][4 * q + 1] * rs); o[1] = pk2(acc[i][j][4 * q + 2] * rs, acc[i][j][4 * q + 3] * rs);
        *(u32x2*)(out + (size_t)m * ZW + n) = o;
      }
  }
}

DI void phase_gemm1(const Params& p, int l, int g, char* smem) {
  const int tid = opq((int)threadIdx.x), lane = tid & 63, w = tid >> 6, r = lane & 31, h = lane >> 5;
  const int bid = blockIdx.x, nb = gridDim.x;
  constexpr int NBIG = 32 * 38;
  for (int t = bid; t < NBIG; t += nb) {
    const int mt = t & 31, nt2 = t >> 5;
    const bf16_t* A = P_hb + ((size_t)g * RG + mt * 256) * DM;
    bf16_t* out = P_zg + (size_t)mt * 256 * ZW;
    const float* ss = P_ss + l * NROWS + g * RG + mt * 256;
    f32x16 acc[2][4];
#pragma unroll
    for (int i = 0; i < 2; ++i) for (int j = 0; j < 4; ++j) acc[i][j] = zero16();
    gemm_main_256(A, DM, P_WinT + ((size_t)l * ZW + nt2 * 256) * DM, DM, DM, smem, acc);
    const int wm = w & 1, wn = w >> 1;
#pragma unroll
    for (int j = 0; j < 4; ++j) {
      const int m = wm * 128 + j * 32 + r;
      const float rs = rsqrtf(ss[m] * (1.f / DM) + EPS);
#pragma unroll
      for (int i = 0; i < 2; ++i)
#pragma unroll
        for (int q = 0; q < 4; ++q) {
          const int n = nt2 * 256 + wn * 64 + i * 32 + 8 * q + 4 * h;
          u32x2 o; o[0] = pk2(acc[i][j][4 * q] * rs, acc[i][j][4 * q + 1] * rs); o[1] = pk2(acc[i][j][4 * q + 2] * rs, acc[i][j][4 * q + 3] * rs);
          *(u32x2*)(out + (size_t)m * ZW + n) = o;
        }
    }
  }
  const int nsmall = 32 + (g == 0 ? 77 : 0);
  const int first = (nb > 192) ? 192 : 0, nw = nb - first;
  if (bid >= first) {
    for (int s = bid - first; s < nsmall; s += nw) {
      if (s < 32) gemm1_small_tile(p, l, P_hb + ((size_t)g * RG + s * 256) * DM, P_zg + (size_t)s * 256 * ZW, P_ss + l * NROWS + g * RG + s * 256, 76, smem);
      else gemm1_small_tile(p, l, P_hb + (size_t)MROW0 * DM, P_zm, P_ss + l * NROWS + MROW0, s - 32, smem);
    }
  }
}

DI int grab_item(unsigned* ctr, char* smem) {
  volatile int* slot = (volatile int*)(smem + LDS_BYTES - 16);
  __syncthreads();
  if (threadIdx.x == 0) *slot = (int)__hip_atomic_fetch_add(ctr, 1u, __ATOMIC_RELAXED, __HIP_MEMORY_SCOPE_AGENT);
  __syncthreads();
  return *slot;
}

DI void phase_local(const Params& p, int l, int g, char* smem) {
  unsigned* ctr = P_ctrl + 64 + ((l * NGRP + g) * 2 + 0) * 16;
  const int nun = NUNIT + (g == 0 ? 1 : 0);
  const int nitem = NB * 32 + nun * 4;
  for (;;) {
    const int it = grab_item(ctr, smem);
    if (it >= nitem) break;
    if (it < NB * 32) { s5_item(p, l, g, it >> 5, it & 31, smem); continue; }
    const int s = it - NB * 32;
    const int uu = s >> 2, ty = s & 3;
    const UnitD u = make_unit(p, uu);
    if (ty == 0) gla_local<true>(p, u, l, 0, smem);
    else if (ty == 1) gla_local<false>(p, u, l, 0, smem);
    else if (ty == 2) gla_local<false>(p, u, l, 1, smem);
    else lru_local(p, u, l, smem);
  }
}

DI void glu_tile(const Params& p, int l, int bid, char* smem) {
  const int tid = opq((int)threadIdx.x), lane = tid & 63, w = tid >> 6, r = lane & 31, h = lane >> 5, wm = w & 3, wn = w >> 2;
  {
    const bf16_t* A; const bf16_t* zz; bf16_t* ys; int nt;
    if (bid < 128) { const int mt = bid & 31; nt = bid >> 5; A = P_ygg + (size_t)mt * 256 * 512; zz = P_zg + (size_t)mt * 256 * ZW; ys = P_ysg + (size_t)mt * 256 * 2048; }
    else { nt = bid - 128; A = P_ygm; zz = P_zm; ys = P_ysm; }
    f32x16 acc[2][2];
#pragma unroll
    for (int i = 0; i < 2; ++i) for (int j = 0; j < 2; ++j) acc[i][j] = zero16();
    gemm_main(A, 512, P_gluT + ((size_t)l * 512 + nt * 128) * 512, 512, 512, smem, acc, bid >= 128);
#pragma unroll
    for (int j = 0; j < 2; ++j) {
      const int m = wm * 64 + j * 32 + r;
#pragma unroll
      for (int i = 0; i < 2; ++i)
#pragma unroll
        for (int q = 0; q < 4; ++q) {
          const int n = nt * 128 + wn * 64 + i * 32 + 8 * q + 4 * h;
          const u32x2 yv = *(const u32x2*)(A + (size_t)m * 512 + n);
          const u32x2 gv = *(const u32x2*)(zz + (size_t)m * ZW + ZC_SG + n);
          float o4[4];
#pragma unroll
          for (int e = 0; e < 4; ++e) {
            const float y = bf2f((bf16_t)(yv[e >> 1] >> (16 * (e & 1))));
            const float gt = bf2f((bf16_t)(gv[e >> 1] >> (16 * (e & 1))));
            o4[e] = y * sigmoidf_(acc[i][j][4 * q + e] + p.glub[l * 512 + n + e]) * siluf_(gt);
          }
          u32x2 o; o[0] = pk2(o4[0], o4[1]); o[1] = pk2(o4[2], o4[3]);
          *(u32x2*)(ys + (size_t)m * 2048 + 1024 + n) = o;
        }
    }
  }
}

DI void phase_scan_states(const Params& p, int l, int g) {
  const int tid = opq((int)threadIdx.x), bid = blockIdx.x;
  typedef float f32x2 __attribute__((ext_vector_type(2)));
  if (tid < 384) {
    const int e = bid * 384 + tid;
    const bf16_t* pk; bf16_t* ps; const float* dec; const bf16_t* init; size_t pstride; int dstride;
    if (e < 32768) {
      const int bl = e / 16384, rem = e % 16384, el = rem * 2, hd = el / 8192, dk = el % 64;
      pk = (const bf16_t*)P_kvA + (size_t)bl * NCH * 32768 + el; ps = (bf16_t*)P_kvA + (size_t)(NUNIT + bl * NCH) * 32768 + el; pstride = 32768;
      init = (const bf16_t*)P_kvAm + el;
      dec = P_decA + (size_t)bl * NCH * 256 + hd * 64 + dk; dstride = 256;
    } else {
      const int e2 = e - 32768, bl = e2 / 32768, rem = e2 % 32768, el = rem * 2, hd = el / 16384, dk = el % 128;
      pk = (const bf16_t*)P_kvB + (size_t)bl * NCH * 65536 + el; ps = (bf16_t*)P_kvB + (size_t)(NUNIT + bl * NCH) * 65536 + el; pstride = 65536;
      init = (const bf16_t*)P_kvBm + el;
      dec = P_decB + (size_t)bl * NCH * 512 + hd * 128 + dk; dstride = 512;
    }
    f32x2 s;
    { const unsigned iv = *(const unsigned*)init; s[0] = bf2f((bf16_t)iv); s[1] = bf2f((bf16_t)(iv >> 16)); }
#pragma unroll 1
    for (int c0 = 0; c0 < NCH; c0 += SCAN_U) {
      unsigned cur[SCAN_U]; f32x2 dd[SCAN_U];
#pragma unroll
      for (int i = 0; i < SCAN_U; ++i) { cur[i] = __builtin_nontemporal_load((const unsigned*)(pk + (size_t)(c0 + i) * pstride)); dd[i] = *(const f32x2*)(dec + (size_t)(c0 + i) * dstride); }
#pragma unroll
      for (int i = 0; i < SCAN_U; ++i) {
        *(unsigned*)(ps + (size_t)(c0 + i) * pstride) = pk2(s[0], s[1]);
        s[0] = dd[i][0] * s[0] + bf2f((bf16_t)cur[i]);
        s[1] = dd[i][1] * s[1] + bf2f((bf16_t)(cur[i] >> 16));
      }
    }
  } else if (bid < 8) {
    const int e = bid * 128 + (tid - 384), bl = e >> 9, n = e & 511;
    float carry = P_chhm[n];
#pragma unroll 8
    for (int c = 0; c < NCH; ++c) {
      const int ix = (bl * NCH + c) * 512 + n;
      const float a = P_cha[ix], hh = P_chh[ix];
      P_cin[ix] = carry;
      carry = a * carry + hh;
    }
  }
}

DI void phase_output(const Params& p, int l, int g, char* smem) {
  unsigned* ctr = P_ctrl + 64 + ((l * NGRP + g) * 2 + 1) * 16;
  const int nun = NUNIT + (g == 0 ? 1 : 0);
  const int nglu = 128 + (g == 0 ? 4 : 0);
  for (;;) {
    int s = grab_item(ctr, smem);
    if (s >= nglu + nun * 4) break;
    if (s < nglu) { glu_tile(p, l, s, smem); continue; }
    s -= nglu;
    const int ty = s / nun, uu = s % nun;
    const UnitD u = make_unit(p, uu);
    if (ty == 0) gla_out<true>(p, u, l, 0, smem);
    else if (ty == 1) gla_out<false>(p, u, l, 0, smem);
    else if (ty == 2) gla_out<false>(p, u, l, 1, smem);
    else lru_out(p, u, smem);
  }
}

DI void phase_gemm2(const Params& p, int l, int g, char* smem) {
  const int tid = opq((int)threadIdx.x), lane = tid & 63, w = tid >> 6, r = lane & 31, h = lane >> 5, wm = w & 3, wn = w >> 2;
  const int ntile = 256 + (g == 0 ? 8 : 0);
  for (int t = blockIdx.x; t < ntile; t += gridDim.x) {
    const bf16_t* A; const bf16_t* zz; bf16_t* out; int nt;
    if (t < 256) { const int mt = t & 31; nt = t >> 5; A = P_ysg + (size_t)mt * 256 * 2048; zz = P_zg + (size_t)mt * 256 * ZW; out = P_mgd + (size_t)mt * 256 * DM; }
    else { nt = t - 256; A = P_ysm; zz = P_zm; out = P_mgdm; }
    f32x16 macc[2][2];
#pragma unroll
    for (int i = 0; i < 2; ++i) for (int j = 0; j < 2; ++j) macc[i][j] = zero16();
#pragma unroll 1
    for (int nb = 0; nb < 4; ++nb) {
      f32x16 acc[2][2];
#pragma unroll
      for (int i = 0; i < 2; ++i) for (int j = 0; j < 2; ++j) acc[i][j] = zero16();
      gemm_main(A + nb * 512, 2048, P_WbT + (((size_t)l * 4 + nb) * DM + nt * 128) * 512, 512, 512, smem, acc, t >= 256, zz + ZC_MG + nb * 1024 + nt * 128, ZW);
#pragma unroll
      for (int j = 0; j < 2; ++j) {
        const int m = wm * 64 + j * 32 + r;
#pragma unroll
        for (int i = 0; i < 2; ++i)
#pragma unroll
          for (int q = 0; q < 4; ++q) {
            const char* grow = (m < 192) ? (smem + 2 * 49152 + m * 256) : (smem + 0 * 49152 + (m - 192) * 256);
            const u32x2 gv = *(const u32x2*)(grow + (((wn * 8 + i * 4 + q) ^ (m & 15)) << 4) + 8 * h);
#pragma unroll
            for (int e = 0; e < 4; ++e) {
              const float gt = bf2f((bf16_t)(gv[e >> 1] >> (16 * (e & 1))));
              macc[i][j][4 * q + e] += sigmoidf_(gt) * acc[i][j][4 * q + e];
            }
          }
      }
    }
#pragma unroll
    for (int j = 0; j < 2; ++j) {
      const int m = wm * 64 + j * 32 + r;
#pragma unroll
      for (int i = 0; i < 2; ++i)
#pragma unroll
        for (int q = 0; q < 4; ++q) {
          const int n = nt * 128 + wn * 64 + i * 32 + 8 * q + 4 * h;
          u32x2 o; o[0] = pk2(macc[i][j][4 * q], macc[i][j][4 * q + 1]); o[1] = pk2(macc[i][j][4 * q + 2], macc[i][j][4 * q + 3]);
          *(u32x2*)(out + (size_t)m * DM + n) = o;
        }
    }
  }
}

DI void phase_gemm3(const Params& p, int l, int g, char* smem) {
  const int tid = opq((int)threadIdx.x), lane = tid & 63, w = tid >> 6, r = lane & 31, h = lane >> 5, wm = w & 3, wn = w >> 2;
  const int ntile = 256 + (g == 0 ? 8 : 0);
  for (int t = blockIdx.x; t < ntile; t += gridDim.x) {
    const bf16_t* A; const float* hin; float* hout; bf16_t* hb; float* ss; int nt;
    if (t < 256) {
      const int mt = t & 31; nt = t >> 5; const size_t row0 = (size_t)g * RG + mt * 256;
      A = P_mgd + (size_t)mt * 256 * DM; hin = (l == 0 ? p.x : p.out) + row0 * DM; hout = p.out + row0 * DM; hb = P_hb + row0 * DM; ss = P_ss + (l + 1) * NROWS + row0;
    } else { nt = t - 256; A = P_mgdm; hin = P_hmeta; hout = P_hmeta; hb = P_hb + (size_t)MROW0 * DM; ss = P_ss + (l + 1) * NROWS + MROW0; }
    f32x16 acc[2][2];
#pragma unroll
    for (int i = 0; i < 2; ++i) for (int j = 0; j < 2; ++j) acc[i][j] = zero16();
    f32x4 hpre[2][2][4];
#pragma unroll
    for (int j = 0; j < 2; ++j)
#pragma unroll
      for (int i = 0; i < 2; ++i)
#pragma unroll
        for (int q = 0; q < 4; ++q)
          hpre[j][i][q] = *(const f32x4*)(hin + (size_t)(wm * 64 + j * 32 + r) * DM + nt * 128 + wn * 64 + i * 32 + 8 * q + 4 * h);
    gemm_main(A, DM, P_WoutT + ((size_t)l * DM + nt * 128) * DM, DM, DM, smem, acc, t >= 256);
#pragma unroll
    for (int j = 0; j < 2; ++j) {
      const int m = wm * 64 + j * 32 + r;
      float sq = 0.f;
#pragma unroll
      for (int i = 0; i < 2; ++i)
#pragma unroll
        for (int q = 0; q < 4; ++q) {
          const int n = nt * 128 + wn * 64 + i * 32 + 8 * q + 4 * h;
          f32x4 hv = hpre[j][i][q];
#pragma unroll
          for (int e = 0; e < 4; ++e) { hv[e] += acc[i][j][4 * q + e]; sq += hv[e] * hv[e]; }
          *(f32x4*)(hout + (size_t)m * DM + n) = hv;
          if (l == 0) { u32x2 o; o[0] = pk2(hv[0], hv[1]); o[1] = pk2(hv[2], hv[3]); *(u32x2*)(hb + (size_t)m * DM + n) = o; }
        }
      sq += __shfl_xor(sq, 32);
      if (h == 0) atomicAdd(ss + m, sq);
    }
  }
}

DI void phase_final(const Params& p) {
  const int tid = opq((int)threadIdx.x), lane = tid & 63, gw = blockIdx.x * 8 + (tid >> 6), ngw = gridDim.x * 8;
  for (int row = gw; row < MROW0; row += ngw) {
    const float rs = rsqrtf(P_ss[2 * NROWS + row] * (1.f / DM) + EPS);
    float* o = p.out + (size_t)row * DM;
#pragma unroll
    for (int q = 0; q < 4; ++q) {
      f32x4 v = *(const f32x4*)(o + q * 256 + lane * 4);
      const f32x4 fn = *(const f32x4*)(p.fnorm + q * 256 + lane * 4);
      v = v * rs * fn;
      __builtin_nontemporal_store(v, (f32x4*)(o + q * 256 + lane * 4));
    }
  }
}

__global__ void __launch_bounds__(NTHR) hybrid_mega(Params p) {
  extern __shared__ __attribute__((aligned(16))) char smem[];
  cg::grid_group grid = cg::this_grid();
  unsigned epoch = xb_xcc_id();
  if (threadIdx.x == 0) {
    volatile __attribute__((address_space(3))) unsigned* st = (volatile __attribute__((address_space(3))) unsigned*)(unsigned)(LDS_BYTES - 32);
    st[0] = 0u; st[1] = 0u;
    (void)xb_add(&(P_ctrl + 1024)[XB_XCNT(epoch)], 1u);
  }
  __syncthreads();
  prologue(p, smem);
  grid.sync();
  phase_gemm1(p, 0, 0, smem); gbar(P_ctrl, epoch);
#pragma unroll 1
  for (int l = 0; l < 2; ++l) {
#pragma unroll 1
    for (int g = 0; g < NGRP; ++g) {
      phase_local(p, l, g, smem); gbar(P_ctrl, epoch);
      phase_scan_states(p, l, g); gbar(P_ctrl, epoch);
      phase_output(p, l, g, smem); gbar(P_ctrl, epoch);
      phase_gemm2(p, l, g, smem); gbar(P_ctrl, epoch);
      phase_gemm3(p, l, g, smem);
      {
        const int gn = (g + 1) % NGRP, ln = l + (g + 1) / NGRP;
        if (ln < 2) phase_gemm1(p, ln, gn, smem);
      }
      gbar(P_ctrl, epoch);
    }
  }
  phase_final(p);
}

extern "C" void kernel_launch(void* const* d_in, const int* in_sizes, int n_in, void* d_out, int out_size, void* d_ws, size_t ws_size, hipStream_t stream) {
  Params p;
  memset(&p, 0, sizeof(p));
  const float* const* in = (const float* const*)d_in;
  p.x = in[0]; p.meta = in[1]; p.lbl = in[2]; p.fnorm = in[3]; p.ng = in[4]; p.w_in = in[5]; p.w_br = in[6]; p.w_out = in[7];
  p.w_lr = in[8]; p.b_lr = in[9]; p.gnorm = in[10]; p.hnorm = in[11]; p.lam_re = in[12]; p.lam_im = in[13]; p.log_dt = in[14];
  p.b_re = in[15]; p.b_im = in[16]; p.c_re = in[17]; p.c_im = in[18]; p.s5d = in[19]; p.gluw = in[20]; p.glub = in[21];
  p.convw = in[22]; p.convb = in[23]; p.wa = in[24]; p.ba = in[25]; p.wx = in[26]; p.bx = in[27]; p.lam = in[28];
  p.out = (float*)d_out;
  p.ws = (char*)d_ws; const size_t off = WS_NEED;
  static int grid_blocks = 0;
  if (!grid_blocks) {
    if (off > ws_size) { fprintf(stderr, "kernel_launch: workspace too small: need %zu have %zu\n", off, ws_size); grid_blocks = -1; }
    else {
      int dev = 0, cus = 0, per_cu = 0;
      hipGetDevice(&dev);
      hipDeviceGetAttribute(&cus, hipDeviceAttributeMultiprocessorCount, dev);
      hipFuncSetAttribute((const void*)hybrid_mega, hipFuncAttributeMaxDynamicSharedMemorySize, LDS_BYTES);
      hipOccupancyMaxActiveBlocksPerMultiprocessor(&per_cu, hybrid_mega, NTHR, LDS_BYTES);
      if (per_cu < 1) { fprintf(stderr, "kernel_launch: occupancy query returned %d\n", per_cu); grid_blocks = -1; }
      else grid_blocks = cus;
    }
  }
  if (grid_blocks <= 0) return;
  hipMemsetAsync(p.ws + O_ctrl, 0, 20480, stream);
  void* args[] = {&p};
  hipError_t e = hipLaunchCooperativeKernel((void*)hybrid_mega, dim3(grid_blocks), dim3(NTHR), args, LDS_BYTES, stream);
  if (e != hipSuccess) fprintf(stderr, "cooperative launch failed: %s (grid %d)\n", hipGetErrorString(e), grid_blocks);
}
```
